# Optimizing an MI355X kernel written in HIP

```python
import math
import jax
import jax.numpy as jnp
from jax import lax
import numpy as np

D_MODEL = 2048
BATCH = 2
SEQ = 4096
DEPTH = 2

GRID_W = 64
CTX_LEN = 256
F32 = jnp.float32

HY_WIDTH = D_MODEL // 4
LRU_WIDTH = D_MODEL // 4
ATT_WIDTH = D_MODEL // 2
D_MIX = HY_WIDTH + LRU_WIDTH + ATT_WIDTH

HY_GROUPS = 4
HY_ORDER = 2
HY_CONV = 3
HY_BANDS = 8
HY_EMB = 1 + 2 * HY_BANDS
HY_FILTER_HIDDEN = 64
HY_TARGET = 1e-2
HY_SHORT_DECAY_PCT = 0.3
HY_LONG_DECAY_PCT = 1.5
HY_MAX_DECAY = math.log(HY_TARGET) / HY_SHORT_DECAY_PCT
HY_MIN_DECAY = math.log(HY_TARGET) / HY_LONG_DECAY_PCT
HY_IN = (HY_ORDER + 1) * HY_WIDTH

LRU_HEADS = 8
LRU_HEAD_DIM = LRU_WIDTH // LRU_HEADS
LRU_CONV = 4
LRU_C = 8.0
LRU_IN = 2 * LRU_WIDTH

ATT_HEADS = 4
ATT_V_DIM = ATT_WIDTH // ATT_HEADS
ATT_HEAD_DIM = ATT_V_DIM // 2
ATT_QK = ATT_HEADS * 2 * ATT_HEAD_DIM
ATT_IN = 2 * ATT_QK + ATT_WIDTH
Q_BLOCK = 128
ROPE_THETA = 10000.0
ROPE_AXIS_DIM = ATT_HEAD_DIM // 2

D_IN = HY_IN + LRU_IN + ATT_IN

N_EXPERTS = 64
TOP_K = 8
D_EXPERT = 512
D_SHARED = 512
ROUTED_SCALE = 2.5
EXPERT_BLOCK = 128

LN_EPS = 1e-5
DEEPNORM_ALPHA = (2 * DEPTH) ** 0.25
DEEPNORM_BETA = (8 * DEPTH) ** -0.25

kernel_name = 'hybrid_hyena_rglru_diffattn_moe_dit'


def layer_norm(x, gain=None, bias=None):
    xf = x.astype(F32)
    mu = jnp.mean(xf, axis=-1, keepdims=True)
    var = jnp.mean(jnp.square(xf - mu), axis=-1, keepdims=True)
    y = (xf - mu) * lax.rsqrt(var + LN_EPS)
    if gain is not None:
        y = y * gain + bias
    return y.astype(x.dtype)


def modulate(x, shift, scale):
    return layer_norm(x) * (1.0 + scale) + shift


def depthwise_conv(x, w, b, pad_left, pad_right):
    y = lax.conv_general_dilated(
        x, w[:, None, :].astype(x.dtype), window_strides=(1,),
        padding=[(pad_left, pad_right)], dimension_numbers=('NWC', 'WIO', 'NWC'),
        feature_group_count=x.shape[-1])
    return y + b


def split_groups(u):
    return u[..., :HY_IN], u[..., HY_IN:HY_IN + LRU_IN], u[..., HY_IN + LRU_IN:]


def hyena_filter_spectrum(n, w1, b1, w2, b2, w3, freq):
    pos = jnp.arange(n, dtype=F32)
    t = (pos / max(n - 1, 1))[:, None]
    bands = jnp.linspace(1e-4, HY_BANDS - 1, HY_BANDS, dtype=F32)
    ang = (2.0 * math.pi / n) * pos[:, None] * bands
    feats = jnp.concatenate([t, jnp.cos(ang), -jnp.sin(ang)], axis=-1)
    hid = jnp.sin(freq * (feats @ w1 + b1))
    hid = jnp.sin(freq * (hid @ w2 + b2))
    filt = (hid @ w3).astype(F32).reshape(n, 2, HY_ORDER, HY_WIDTH)
    decay = jnp.abs(jnp.linspace(HY_MIN_DECAY, HY_MAX_DECAY, HY_WIDTH, dtype=F32))
    filt = filt * jnp.exp(-t * decay)[:, None, None, :]
    fwd, bwd = filt[:, 0], filt[:, 1]
    two_sided = jnp.concatenate([fwd, jnp.zeros_like(fwd[:1]), jnp.flip(bwd[1:], axis=0)], axis=0)
    two_sided = two_sided / jnp.sum(jnp.abs(two_sided), axis=0, keepdims=True)
    return jnp.fft.rfft(two_sided, axis=0)


def hyena_mixer(u, conv_w, conv_b, w1, b1, w2, b2, w3, freq, skip):
    n = u.shape[1]
    u = depthwise_conv(u, conv_w, conv_b, HY_CONV // 2, HY_CONV - 1 - HY_CONV // 2).astype(F32)
    gates = (u[..., :HY_WIDTH], u[..., HY_WIDTH:2 * HY_WIDTH])
    z = u[..., 2 * HY_WIDTH:]
    spec = hyena_filter_spectrum(n, w1, b1, w2, b2, w3, freq)
    for o in range(HY_ORDER):
        zc = jnp.fft.irfft(jnp.fft.rfft(z, n=2 * n, axis=1) * spec[None, :, o], n=2 * n, axis=1)[:, :n]
        z = gates[o] * (zc + skip[o] * z)
    return z


def rglru_coeffs(xr, wa, ba, wx, bx, lam):
    bsz, n, _ = xr.shape
    xf = xr.astype(F32)
    xh = xf.reshape(bsz, n, LRU_HEADS, LRU_HEAD_DIM)
    r = jax.nn.sigmoid(jnp.einsum('blhi,hij->blhj', xh, wa).reshape(bsz, n, LRU_WIDTH) + ba)
    i = jax.nn.sigmoid(jnp.einsum('blhi,hij->blhj', xh, wx).reshape(bsz, n, LRU_WIDTH) + bx)
    log_a = -LRU_C * r * jax.nn.softplus(-lam)
    a = jnp.exp(log_a)
    b = jnp.sqrt(-jnp.expm1(2.0 * log_a)) * (i * xf)
    return a, b


def _affine_combine(left, right):
    a_l, b_l = left
    a_r, b_r = right
    return a_l * a_r, a_r * b_l + b_r


def linear_scan(a, b, h0, reverse):
    if reverse:
        a, b = jnp.flip(a, axis=1), jnp.flip(b, axis=1)
    a_cum, b_cum = lax.associative_scan(_affine_combine, (a, b), axis=1)
    h = a_cum * h0[:, None, :] + b_cum
    return jnp.flip(h, axis=1) if reverse else h


def rglru_mixer(u_lat, u_ctx, conv_w, conv_b, wa, ba, wx, bx, lam, need_ctx):
    def recurrent_input(u):
        return depthwise_conv(u[..., LRU_WIDTH:], conv_w, conv_b, LRU_CONV // 2, LRU_CONV - 1 - LRU_CONV // 2)
    xr_lat, xr_ctx = recurrent_input(u_lat), recurrent_input(u_ctx)
    h_lat = jnp.zeros(xr_lat.shape, F32)
    ctx_states = []
    for d, reverse in enumerate((False, True)):
        a_c, b_c = rglru_coeffs(xr_ctx, wa[d], ba[d], wx[d], bx[d], lam[d])
        hs_c = linear_scan(a_c, b_c, jnp.zeros_like(a_c[:, 0]), reverse)
        h_end = hs_c[:, 0] if reverse else hs_c[:, -1]
        a_l, b_l = rglru_coeffs(xr_lat, wa[d], ba[d], wx[d], bx[d], lam[d])
        h_lat = h_lat + linear_scan(a_l, b_l, h_end, reverse)
        ctx_states.append(hs_c)
    y_lat = h_lat * jax.nn.gelu(u_lat[..., :LRU_WIDTH].astype(F32))
    y_ctx = None
    if need_ctx:
        y_ctx = (ctx_states[0] + ctx_states[1]) * jax.nn.gelu(u_ctx[..., :LRU_WIDTH].astype(F32))
    return y_lat, y_ctx


def axial_rope_tables(n):
    rows = n // GRID_W
    row = jnp.broadcast_to(jnp.arange(rows, dtype=F32)[:, None], (rows, GRID_W)).reshape(-1)
    col = jnp.broadcast_to(jnp.arange(GRID_W, dtype=F32)[None, :], (rows, GRID_W)).reshape(-1)
    inv = ROPE_THETA ** (-jnp.arange(0, ROPE_AXIS_DIM, 2, dtype=F32) / ROPE_AXIS_DIM)
    ang = jnp.stack([row[:, None] * inv, col[:, None] * inv], axis=1)
    return jnp.cos(ang), jnp.sin(ang)


def apply_axial_rope(x, cos, sin):
    xs = x.reshape(x.shape[:-1] + (2, 2, ROPE_AXIS_DIM // 2))
    x1, x2 = xs[..., 0, :], xs[..., 1, :]
    cb, sb = cos[None, :, None, None], sin[None, :, None, None]
    out = jnp.stack([x1 * cb - x2 * sb, x2 * cb + x1 * sb], axis=-2)
    return out.reshape(x.shape)


def diff_attend(q, k, v, lam):
    s = jnp.einsum('bqhmd,bkhmd->bhmqk', q, k).astype(F32) * (ATT_HEAD_DIM ** -0.5)
    p = jax.nn.softmax(s, axis=-1)
    w = p[:, :, 0] - lam * p[:, :, 1]
    return jnp.einsum('bhqk,bkhe->bqhe', w, v.astype(F32))


def head_rms_norm(o, gain, lam_init):
    of = o.astype(F32)
    y = of * lax.rsqrt(jnp.mean(of * of, axis=-1, keepdims=True) + LN_EPS) * gain * (1.0 - lam_init)
    return y.reshape(o.shape[0], o.shape[1], -1)


def diff_attention_mixer(u_lat, u_ctx, lam_vecs, subln_gain, lam_init, need_ctx):
    bsz, n_lat, _ = u_lat.shape

    def split_qkv(u):
        bb, n, _ = u.shape
        q = u[..., :ATT_QK].reshape(bb, n, ATT_HEADS, 2, ATT_HEAD_DIM)
        k = u[..., ATT_QK:2 * ATT_QK].reshape(bb, n, ATT_HEADS, 2, ATT_HEAD_DIM)
        v = u[..., 2 * ATT_QK:].reshape(bb, n, ATT_HEADS, ATT_V_DIM)
        return q, k, v

    q_l, k_l, v_l = split_qkv(u_lat)
    q_c, k_c, v_c = split_qkv(u_ctx)
    cos, sin = axial_rope_tables(n_lat)
    q_l = apply_axial_rope(q_l, cos, sin)
    k_l = apply_axial_rope(k_l, cos, sin)
    lv = lam_vecs.astype(F32)
    lam = jnp.exp(jnp.sum(lv[0] * lv[1])) - jnp.exp(jnp.sum(lv[2] * lv[3])) + lam_init
    k_all = jnp.concatenate([k_c, k_l], axis=1)
    v_all = jnp.concatenate([v_c, v_l], axis=1)
    n_blk = n_lat // Q_BLOCK
    q_blocks = jnp.moveaxis(q_l.reshape(bsz, n_blk, Q_BLOCK, ATT_HEADS, 2, ATT_HEAD_DIM), 1, 0)
    o = lax.map(lambda qb: diff_attend(qb, k_all, v_all, lam), q_blocks)
    o_lat = jnp.moveaxis(o, 0, 1).reshape(bsz, n_lat, ATT_HEADS, ATT_V_DIM)
    y_lat = head_rms_norm(o_lat, subln_gain, lam_init)
    y_ctx = head_rms_norm(diff_attend(q_c, k_c, v_c, lam), subln_gain, lam_init) if need_ctx else None
    return y_lat, y_ctx


def moe_ffn(h, router_w, router_b, w_gate, w_up, w_down, sh_gate, sh_up, sh_down):
    n_tok, d = h.shape
    scores = jax.nn.sigmoid((h @ router_w).astype(F32))
    _, top_idx = lax.top_k(scores + router_b.astype(F32), TOP_K)
    top_s = jnp.take_along_axis(scores, top_idx, axis=1)
    top_w = top_s / jnp.sum(top_s, axis=-1, keepdims=True) * ROUTED_SCALE
    n_assign = n_tok * TOP_K
    flat_e = top_idx.reshape(-1)
    order = jnp.argsort(flat_e)
    sorted_e = flat_e[order]
    counts = jnp.bincount(flat_e, length=N_EXPERTS)
    padded = (counts + EXPERT_BLOCK - 1) // EXPERT_BLOCK * EXPERT_BLOCK
    padded_end = jnp.cumsum(padded)
    start = jnp.cumsum(counts) - counts
    dest = (padded_end - padded)[sorted_e] + jnp.arange(n_assign) - start[sorted_e]
    n_blocks = -(-n_assign // EXPERT_BLOCK) + N_EXPERTS
    n_rows = n_blocks * EXPERT_BLOCK
    row_tok = jnp.zeros((n_rows,), jnp.int32).at[dest].set((order // TOP_K).astype(jnp.int32))
    row_w = jnp.zeros((n_rows,), F32).at[dest].set(top_w.reshape(-1)[order])
    block_e = jnp.minimum(
        jnp.searchsorted(padded_end, jnp.arange(n_blocks) * EXPERT_BLOCK, side='right'), N_EXPERTS - 1)

    def expert_block(args):
        tok, wgt, e = args
        xb = h[tok]
        act = jax.nn.silu(xb @ w_gate[e]) * (xb @ w_up[e])
        return (act @ w_down[e]).astype(F32) * wgt[:, None]

    y = lax.map(expert_block, (row_tok.reshape(n_blocks, EXPERT_BLOCK),
                               row_w.reshape(n_blocks, EXPERT_BLOCK), block_e))
    routed = jnp.zeros((n_tok, d), F32).at[row_tok].add(y.reshape(n_rows, d))
    shared = (jax.nn.silu(h @ sh_gate) * (h @ sh_up)) @ sh_down
    return routed + shared


def setup_inputs(seed: int = 0) -> dict:
    key = jax.random.key(seed)
    ks = iter(jax.random.split(key, 48))

    def nrm(shape, scale):
        return jax.random.normal(next(ks), shape, F32) * scale

    L, D = DEPTH, D_MODEL
    a_base = jax.random.uniform(next(ks), (L, 2, LRU_WIDTH), F32, 0.9, 0.999) ** (1.0 / LRU_C)
    return {
        'x': nrm((BATCH, SEQ, D), 1.0),
        'c': nrm((BATCH, D), 1.0),
        'ctx': nrm((BATCH, CTX_LEN, D), 1.0),
        'c_ctx': nrm((D,), 1.0),
        'ada_w': nrm((L, D, 6 * D), 0.5 * D ** -0.5),
        'ada_b': nrm((L, 6 * D), 0.02),
        'w_in': nrm((L, D, D_IN), D ** -0.5),
        'hy_conv_w': nrm((L, HY_CONV, HY_IN), HY_CONV ** -0.5),
        'hy_conv_b': nrm((L, HY_IN), 0.02),
        'hy_w1': nrm((L, HY_EMB, HY_FILTER_HIDDEN), HY_EMB ** -0.5),
        'hy_b1': nrm((L, HY_FILTER_HIDDEN), 0.1),
        'hy_w2': nrm((L, HY_FILTER_HIDDEN, HY_FILTER_HIDDEN), HY_FILTER_HIDDEN ** -0.5),
        'hy_b2': nrm((L, HY_FILTER_HIDDEN), 0.1),
        'hy_w3': nrm((L, HY_FILTER_HIDDEN, 2 * HY_ORDER * HY_WIDTH), HY_FILTER_HIDDEN ** -0.5),
        'hy_freq': 1.0 + nrm((L, HY_FILTER_HIDDEN), 0.1),
        'hy_skip': nrm((L, HY_ORDER, HY_WIDTH), 0.5),
        'lru_conv_w': nrm((L, LRU_CONV, LRU_WIDTH), LRU_CONV ** -0.5),
        'lru_conv_b': nrm((L, LRU_WIDTH), 0.02),
        'lru_wa': nrm((L, 2, LRU_HEADS, LRU_HEAD_DIM, LRU_HEAD_DIM), LRU_HEAD_DIM ** -0.5),
        'lru_ba': nrm((L, 2, LRU_WIDTH), 0.02),
        'lru_wx': nrm((L, 2, LRU_HEADS, LRU_HEAD_DIM, LRU_HEAD_DIM), LRU_HEAD_DIM ** -0.5),
        'lru_bx': nrm((L, 2, LRU_WIDTH), 0.02),
        'lru_lambda': jnp.log(a_base) - jnp.log1p(-a_base),
        'att_lambda': nrm((L, 4, ATT_HEAD_DIM), 0.1),
        'att_subln': 1.0 + nrm((L, ATT_V_DIM), 0.02),
        'w_out': nrm((L, D_MIX, D), DEEPNORM_BETA * D_MIX ** -0.5),
        'ln_g': 1.0 + nrm((L, 2, D), 0.02),
        'ln_b': nrm((L, 2, D), 0.02),
        'router_w': nrm((L, D, N_EXPERTS), D ** -0.5),
        'router_b': nrm((L, N_EXPERTS), 0.01),
        'exp_w_gate': nrm((L, N_EXPERTS, D, D_EXPERT), D ** -0.5),
        'exp_w_up': nrm((L, N_EXPERTS, D, D_EXPERT), D ** -0.5),
        'exp_w_down': nrm((L, N_EXPERTS, D_EXPERT, D), DEEPNORM_BETA * D_EXPERT ** -0.5),
        'sh_w_gate': nrm((L, D, D_SHARED), D ** -0.5),
        'sh_w_up': nrm((L, D, D_SHARED), D ** -0.5),
        'sh_w_down': nrm((L, D_SHARED, D), DEEPNORM_BETA * D_SHARED ** -0.5),
    }


def reference(x, c, ctx, c_ctx, ada_w, ada_b, w_in, hy_conv_w, hy_conv_b, hy_w1, hy_b1, hy_w2,
              hy_b2, hy_w3, hy_freq, hy_skip, lru_conv_w, lru_conv_b, lru_wa, lru_ba, lru_wx,
              lru_bx, lru_lambda, att_lambda, att_subln, w_out, ln_g, ln_b, router_w, router_b,
              exp_w_gate, exp_w_up, exp_w_down, sh_w_gate, sh_w_up, sh_w_down):
    x_lat, x_ctx = x, ctx
    for l in range(DEPTH):
        need_ctx = l < DEPTH - 1
        lam_init = 0.8 - 0.6 * math.exp(-0.3 * l)
        mod_lat = (jax.nn.silu(c) @ ada_w[l] + ada_b[l])[:, None, :]
        mod_ctx = (jax.nn.silu(c_ctx) @ ada_w[l] + ada_b[l])[None, None, :]
        sh1_l, sc1_l, g1_l, sh2_l, sc2_l, g2_l = jnp.split(mod_lat, 6, axis=-1)
        sh1_c, sc1_c, g1_c, sh2_c, sc2_c, g2_c = jnp.split(mod_ctx, 6, axis=-1)
        hy_args = (hy_conv_w[l], hy_conv_b[l], hy_w1[l], hy_b1[l], hy_w2[l], hy_b2[l],
                   hy_w3[l], hy_freq[l], hy_skip[l])

        hy_l, lru_l, att_l = split_groups(modulate(x_lat, sh1_l, sc1_l) @ w_in[l])
        hy_c, lru_c, att_c = split_groups(modulate(x_ctx, sh1_c, sc1_c) @ w_in[l])
        y_hy_l = hyena_mixer(hy_l, *hy_args)
        y_lru_l, y_lru_c = rglru_mixer(lru_l, lru_c, lru_conv_w[l], lru_conv_b[l], lru_wa[l], lru_ba[l],
                                       lru_wx[l], lru_bx[l], lru_lambda[l], need_ctx)
        y_att_l, y_att_c = diff_attention_mixer(att_l, att_c, att_lambda[l], att_subln[l], lam_init, need_ctx)
        mix_l = jnp.concatenate([y_hy_l, y_lru_l, y_att_l], axis=-1) @ w_out[l]
        x_lat = layer_norm(DEEPNORM_ALPHA * x_lat + g1_l * mix_l, ln_g[l, 0], ln_b[l, 0])
        if need_ctx:
            mix_c = jnp.concatenate([hyena_mixer(hy_c, *hy_args), y_lru_c, y_att_c], axis=-1) @ w_out[l]
            x_ctx = layer_norm(DEEPNORM_ALPHA * x_ctx + g1_c * mix_c, ln_g[l, 0], ln_b[l, 0])

        f_lat = modulate(x_lat, sh2_l, sc2_l).reshape(-1, D_MODEL)
        n_lat_tok = f_lat.shape[0]
        if need_ctx:
            tokens = jnp.concatenate([f_lat, modulate(x_ctx, sh2_c, sc2_c).reshape(-1, D_MODEL)], axis=0)
        else:
            tokens = f_lat
        ffn = moe_ffn(tokens, router_w[l], router_b[l], exp_w_gate[l], exp_w_up[l], exp_w_down[l],
                      sh_w_gate[l], sh_w_up[l], sh_w_down[l])
        x_lat = layer_norm(DEEPNORM_ALPHA * x_lat + g2_l * ffn[:n_lat_tok].reshape(x_lat.shape),
                           ln_g[l, 1], ln_b[l, 1])
        if need_ctx:
            x_ctx = layer_norm(DEEPNORM_ALPHA * x_ctx + g2_c * ffn[n_lat_tok:].reshape(x_ctx.shape),
                               ln_g[l, 1], ln_b[l, 1])
    return x_lat
```

```cpp
#include <hip/hip_runtime.h>
#include <cstdio>
#include <cstdint>

#define LAS __attribute__((address_space(3)))
#define GAS __attribute__((address_space(1)))
typedef unsigned short bf16;
typedef short bf16x8 __attribute__((ext_vector_type(8)));
typedef short s16x4 __attribute__((ext_vector_type(4)));
typedef float f32x4 __attribute__((ext_vector_type(4)));
typedef float f32x2 __attribute__((ext_vector_type(2)));
typedef float f32x16 __attribute__((ext_vector_type(16)));
typedef unsigned u32x4 __attribute__((ext_vector_type(4)));
typedef unsigned u32x2 __attribute__((ext_vector_type(2)));

#ifndef FP8_OUT
#define FP8_OUT 1
#endif
constexpr float MIX8_SCALE = 1.0f;
#ifndef FP8_IN
#define FP8_IN 0
#endif
#ifndef MK_N_LAUNCHES
#define MK_N_LAUNCHES 1
#ifndef YG_NT
#define YG_NT 0
#endif
#endif

constexpr int NB = 2, SEQ = 4096, CTXL = 256, DM = 2048, NLAYER = 2, GRIDW = 64;
constexpr int RB = CTXL + SEQ;
constexpr int M = NB * RB;
constexpr int DIN = 5632, NHY = 1536, NREST = 4096;
constexpr int UC_GATE = 0, UC_REC = 512, UC_Q = 1024, UC_K = 2048, UC_V = 3072;
constexpr int HYW = 512, NEXP = 64, NEX1 = 65, TOPK = 8, DEXP = 512, LCAP = M;
constexpr int LRU_CH = 128, LRU_NCH = RB / LRU_CH;
constexpr float LN_EPS = 1e-5f, ALPHA = 1.41421356237309515f, ROUTED_SCALE = 2.5f;
constexpr int NWAVES = 8, NTHR = 512;
constexpr int ACT_TILES_MAX = (M * TOPK) / 256 + NEXP + M / 256;

constexpr size_t al256(size_t x) { return (x + 255) / 256 * 256; }
constexpr size_t WS_CTL = 0, CTL_ZERO_BYTES = 1u << 20;
constexpr size_t WS_MOD   = CTL_ZERO_BYTES;
constexpr size_t WS_ROPE  = WS_MOD + al256((size_t)NLAYER * 3 * 6 * DM * 4);
constexpr size_t WS_HIDB  = WS_ROPE + al256(64 * 32 * 8);
constexpr size_t WS_W3T   = WS_HIDB + al256((size_t)NLAYER * RB * 64 * 2);
constexpr size_t WS_FILT  = WS_W3T + al256((size_t)NLAYER * 2048 * 64 * 2);
constexpr size_t WS_RWT   = WS_FILT + al256((size_t)NLAYER * 2048 * RB * 4);
constexpr size_t WS_TW    = WS_RWT + al256((size_t)NLAYER * 2 * NEXP * DM * 2);
constexpr size_t WS_LAMS  = WS_TW + 65536;
constexpr size_t WS_LRUAGG = WS_LAMS + 256;
constexpr size_t WS_LIST  = WS_LRUAGG + al256((size_t)NB * 2 * LRU_NCH * 512 * 8);
constexpr size_t WS_WINT  = WS_LIST + al256((size_t)3 * NEXP * LCAP * 4);
constexpr size_t WS_WOUTT = WS_WINT + al256((size_t)NLAYER * DIN * DM * 2);
constexpr size_t WS_W1T   = WS_WOUTT + al256((size_t)NLAYER * DM * DM * 2);
constexpr size_t WS_W2T   = WS_W1T + al256((size_t)NLAYER * NEX1 * 1024 * DM * 2);
constexpr size_t WS_A1    = WS_W2T + al256((size_t)NLAYER * NEX1 * DM * DEXP * 2);
constexpr size_t WS_HYT   = WS_A1 + al256((size_t)M * DM * 2);
constexpr size_t WS_U     = WS_HYT + al256((size_t)NHY * M * 2);
constexpr size_t WS_YHT   = WS_U + al256((size_t)M * NREST * 2);
constexpr size_t WS_OATT  = WS_YHT + al256((size_t)HYW * M * 2);
constexpr size_t WS_MIX   = WS_OATT + al256((size_t)2 * M * 1024 * 4);
constexpr size_t WS_RBUF  = WS_MIX + al256((size_t)M * DM * 2);
constexpr size_t WS_XA    = WS_RBUF + al256((size_t)M * DM * 4);
constexpr size_t WS_XB    = WS_XA + al256((size_t)M * DM * 4);
constexpr size_t WS_H2    = WS_XB + al256((size_t)M * DM * 4);
constexpr size_t WS_H2F   = WS_H2 + al256((size_t)M * DM * 2);
constexpr size_t WS_ACT   = WS_H2F + al256((size_t)M * DM * 4);
constexpr size_t WS_YG    = WS_ACT + al256((size_t)ACT_TILES_MAX * 256 * DEXP * 2);
constexpr size_t WS_END   = WS_YG + al256((size_t)M * 9 * DM * 2);
constexpr int CW_TMO = 0;
constexpr int CW_CNT = 16384, CNT_ST = 64;
constexpr int CW_BAR = 4096;

constexpr int RING_BYTES = 143360;
constexpr int LDSCTL_OFF = RING_BYTES, LDSCTL_BYTES = 2048;
constexpr int LDS_BYTES = RING_BYTES + LDSCTL_BYTES;
constexpr int LW_BAR = 0, LW_TPRE = 16, LW_MISC = 128, LW_FPRE = 256;

#define RLX_AGENT __ATOMIC_RELAXED, __HIP_MEMORY_SCOPE_AGENT
#define LDS_WAIT() asm volatile("s_waitcnt lgkmcnt(0)" ::: "memory")
#define VM_WAIT() asm volatile("s_waitcnt vmcnt(0)" ::: "memory")

__device__ __forceinline__ unsigned pk_bf16(float lo, float hi) { unsigned r; asm volatile("v_cvt_pk_bf16_f32 %0, %1, %2" : "=v"(r) : "v"(lo), "v"(hi)); return r; }
__device__ __forceinline__ float bf2f(bf16 b) { return __uint_as_float(((unsigned)b) << 16); }
__device__ __forceinline__ bf16 f2bf(float f) { return (bf16)(pk_bf16(f, 0.f) & 0xffffu); }
__device__ __forceinline__ float wave_sum(float v) {
#pragma unroll
    for (int o = 1; o < 64; o <<= 1) v += __shfl_xor(v, o);
    return v;
}
__device__ __forceinline__ float wave_max(float v) {
#pragma unroll
    for (int o = 1; o < 64; o <<= 1) v = fmaxf(v, __shfl_xor(v, o));
    return v;
}
__device__ __forceinline__ float fast_exp(float x) { return __builtin_amdgcn_exp2f(x * 1.4426950408889634f); }
__device__ __forceinline__ float sigm(float x) { return __builtin_amdgcn_rcpf(1.f + fast_exp(-x)); }
__device__ __forceinline__ float silu_f(float x) { return x * sigm(x); }
__device__ __forceinline__ float gelu_tanh(float x) { const float u = 0.7978845608028654f * (x + 0.044715f * x * x * x); const float e = fast_exp(2.f * u); return 0.5f * x * (2.f - 2.f * __builtin_amdgcn_rcpf(e + 1.f)); }
__device__ __forceinline__ float sin_rev(float r) { r -= rintf(r); return __builtin_amdgcn_sinf(r); }
__device__ __forceinline__ float cos_rev(float r) { r -= rintf(r); return __builtin_amdgcn_cosf(r); }
__device__ __forceinline__ float sin_rad(float x) { return sin_rev(x * 0.15915494309189535f); }

__device__ __forceinline__ int cvt2_fp8(float a, float b, int old, bool hi) { a = fminf(fmaxf(a, -448.f), 448.f); b = fminf(fmaxf(b, -448.f), 448.f); return hi ? __builtin_amdgcn_cvt_pk_fp8_f32(a, b, old, true) : __builtin_amdgcn_cvt_pk_fp8_f32(a, b, old, false); }
__device__ __forceinline__ int lane_now() { int l; asm volatile("v_mbcnt_lo_u32_b32 %0, -1, 0\n\tv_mbcnt_hi_u32_b32 %0, -1, %0" : "=v"(l)); return l; }
__device__ __forceinline__ int row_mod(int r) { const int b = r >= RB ? 1 : 0; const int p = r - b * RB; return p < CTXL ? 2 : b; }
__device__ __forceinline__ const float* xin_row(const float* x, const float* ctx, int r) { const int b = r >= RB ? 1 : 0; const int p = r - b * RB; return p < CTXL ? ctx + ((size_t)b * CTXL + p) * DM : x + ((size_t)b * SEQ + (p - CTXL)) * DM; }

#define XB_TMO      128
#define XB_XCNT(j)  (256  + 64 * (j))
#define XB_XSUB(j)  (1280 + 64 * (j))
#define XB_XGEN(j)  (2304 + 64 * (j))
#define XB_TOP      3328
#define XB_TOPGEN   3392
#define XCD_BAR_WORDS 3456
#define XB_SPIN_CAP (1u << 18)
__device__ __forceinline__ unsigned xb_ld(unsigned* p)              { return __hip_atomic_load(p, __ATOMIC_RELAXED, __HIP_MEMORY_SCOPE_AGENT); }
__device__ __forceinline__ unsigned xb_add(unsigned* p, unsigned v) { return __hip_atomic_fetch_add(p, v, __ATOMIC_RELAXED, __HIP_MEMORY_SCOPE_AGENT); }
__device__ __forceinline__ unsigned xb_xcc_id() { return (unsigned)__builtin_amdgcn_s_getreg((3 << 11) | 20) & 0xFu; }
#define XB_SPIN(cond, bar) do { unsigned _sp = 0; while (cond) { __builtin_amdgcn_s_sleep(1); \
    if ((++_sp & 255u) == 0u) { if (xb_ld(&(bar)[XB_TMO])) break; if (_sp > XB_SPIN_CAP) { atomicAdd(&(bar)[XB_TMO], 1u); break; } } } } while (0)
struct XcdBarrier { unsigned* bar; unsigned x; volatile LAS unsigned* st; };
__device__ __forceinline__ XcdBarrier xcd_barrier_post(unsigned* bar, volatile LAS unsigned* st, bool t0) {
    XcdBarrier b; b.bar = bar; b.x = xb_xcc_id(); b.st = st;
    if (t0) (void)xb_add(&bar[XB_XCNT(b.x)], 1u);
    return b;
}
__device__ __forceinline__ void xcd_barrier_complete(unsigned* bar, unsigned x, unsigned& nloc, unsigned& nx) {
    const unsigned G = gridDim.x * gridDim.y * gridDim.z;
    unsigned sum, cnt, mine, sp = 0u;
    for (;;) {
        sum = 0u; cnt = 0u; mine = 0u;
#pragma unroll
        for (unsigned j = 0; j < 16; ++j) { const unsigned c = xb_ld(&bar[XB_XCNT(j)]); sum += c; cnt += (c > 0u) ? 1u : 0u; mine = (j == x) ? c : mine; }
        if (sum == G) break;
        __builtin_amdgcn_s_sleep(1);
        if ((++sp & 255u) == 0u) { if (xb_ld(&bar[XB_TMO])) break; if (sp > XB_SPIN_CAP) { atomicAdd(&bar[XB_TMO], 1u); break; } }
    }
    nloc = mine > 0u ? mine : 1u; nx = cnt > 0u ? cnt : 1u;
}
__device__ __forceinline__ void xcd_barrier(const XcdBarrier& b, bool t0) {
    asm volatile("s_waitcnt vmcnt(0)" ::: "memory");
    __syncthreads();
    if (t0) {
        unsigned* bar = b.bar;
        __builtin_amdgcn_s_waitcnt(0);
        unsigned nloc = b.st[0], nx = b.st[1];
        if (nloc == 0u) { xcd_barrier_complete(bar, b.x, nloc, nx); b.st[0] = nloc; b.st[1] = nx; }
        const unsigned old = xb_add(&bar[XB_XSUB(b.x)], 1u);
        const unsigned gen = old / nloc;
        if (old + 1u == (gen + 1u) * nloc) {
            __builtin_amdgcn_fence(__ATOMIC_RELEASE, "agent");
            asm volatile("s_waitcnt vmcnt(0)" ::: "memory");
            const unsigned og = xb_add(&bar[XB_TOP], 1u);
            const unsigned tg = og / nx;
            if (og + 1u == (tg + 1u) * nx) xb_add(&bar[XB_TOPGEN], 1u);
            else XB_SPIN(xb_ld(&bar[XB_TOPGEN]) == tg, bar);
            __builtin_amdgcn_fence(__ATOMIC_ACQUIRE, "agent");
            xb_add(&bar[XB_XGEN(b.x)], 1u);
            asm volatile("s_waitcnt vmcnt(0)" ::: "memory");
        } else {
            XB_SPIN(xb_ld(&bar[XB_XGEN(b.x)]) == gen, bar);
            __builtin_amdgcn_fence(__ATOMIC_ACQUIRE, "agent");
            asm volatile("s_waitcnt vmcnt(0)" ::: "memory");
        }
    }
    __syncthreads();
}

__device__ __forceinline__ const float* inp(int i) { asm volatile("" : "+s"(i)); const GAS float* p = ((const GAS float* const*)__builtin_amdgcn_kernarg_segment_ptr())[i]; return (const float*)p; }
__device__ __forceinline__ unsigned char* wsb() { GAS unsigned char* p = ((GAS unsigned char* const*)__builtin_amdgcn_kernarg_segment_ptr())[37]; asm volatile("" : "+s"(p)); return (unsigned char*)p; }
__device__ __forceinline__ float* outb() { GAS float* p = ((GAS float* const*)__builtin_amdgcn_kernarg_segment_ptr())[36]; asm volatile("" : "+s"(p)); return (float*)p; }
enum InIdx { I_X = 0, I_C, I_CTX, I_CCTX, I_ADAW, I_ADAB, I_WIN, I_HYCW, I_HYCB, I_HYW1, I_HYB1, I_HYW2, I_HYB2, I_HYW3, I_HYFREQ, I_HYSKIP, I_LCW, I_LCB, I_LWA, I_LBA, I_LWX, I_LBX, I_LLAM,
             I_ATTLAM, I_SUBLN, I_WOUT, I_LNG, I_LNB, I_RW, I_RB, I_EWG, I_EWU, I_EWD, I_SWG, I_SWU, I_SWD };


namespace pg8 {
constexpr int BM = 256, BK = 64, HALF = 128, HTB = HALF * BK * 2, STAGE_BYTES = 8 * HTB, NXCD = 8, WGM = 8;
__host__ __device__ __forceinline__ int lds_byte(int r, int c) { const int st = (r >> 4) * 2 + (c >> 5), rr = r & 15, cc = c & 31, ob = rr * 64 + cc * 2; return st * 1024 + (ob ^ (((ob >> 9) & 1) << 5)); }
__host__ __device__ __forceinline__ void stage_rc(int b, int& R, int& C) { const int st = b / 1024, sb = b % 1024, swz = sb ^ (((sb >> 9) & 1) << 5); R = (st >> 1) * 16 + swz / 64; C = (st & 1) * 32 + (swz % 64) / 2; }
__host__ __device__ __forceinline__ int perm32(int rho) { const int n = rho >> 4, i = rho & 15; return 8 * (i >> 2) + 4 * n + (i & 3); }

struct Unit { int pm, pn, e, rt; };

struct TileOrder {
    int nM, nN, nwg, G, c;
    __device__ void init(int nM_, int nN_, int G_, int c_) { nM = nM_; nN = nN_; nwg = nM * nN; G = G_; c = c_; }
    __device__ bool tile(int i, int& pm, int& pn) const {
        const long L = (long)i * G + c; if (L >= nwg) return false;
        int wgid = (int)L; { const int q = nwg / NXCD, r = nwg % NXCD, xcd = wgid % NXCD, off = wgid / NXCD; wgid = (xcd < r ? xcd * (q + 1) : r * (q + 1) + (xcd - r) * q) + off; }
        const int nig = WGM * nN, gid = wgid / nig, fm = gid * WGM, gsz = (nM - fm) < WGM ? (nM - fm) : WGM;
        pm = fm + ((wgid % nig) % gsz); pn = (wgid % nig) / gsz; return true;
    }
};
template <int RS> struct PlainSched {
    TileOrder T; const bf16* A; const bf16* Bt; int skipctx; const volatile LAS int* lw;
    __device__ bool next(int i, Unit& u) const { u.e = 0; u.rt = 0; int pm = 0, pn = 0; const bool ok = T.tile(i, pm, pn); if (skipctx) pm += 1 + (pm >= 16 ? 1 : 0);
        int spm = __builtin_amdgcn_readfirstlane(pm), spn = __builtin_amdgcn_readfirstlane(pn), sok = __builtin_amdgcn_readfirstlane(ok ? 1 : 0); asm volatile("" : "+s"(spm), "+s"(spn), "+s"(sok));
        u.pm = spm; u.pn = spn; return sok != 0; }
    __device__ __forceinline__ bool half(const Unit&) const { return lw[0] != 0; }
    __device__ __forceinline__ const char* a_base(const Unit& u) const { return (const char*)A + (size_t)u.pm * 256 * RS; }
    __device__ __forceinline__ const char* b_base(const Unit& u) const { return (const char*)Bt + (size_t)u.pn * 256 * RS; }
    __device__ __forceinline__ void a_offs(const Unit&, unsigned (&o)[2][2], const int (&R)[2], const unsigned (&cb)[2]) const {
#pragma unroll
        for (int h = 0; h < 2; ++h)
#pragma unroll
            for (int i = 0; i < 2; ++i) o[h][i] = (unsigned)((h * HALF + R[i]) * RS) + cb[i];
    }
};

__device__ __forceinline__ unsigned cvt_pk_bf16(float lo, float hi) { unsigned r; asm volatile("v_cvt_pk_bf16_f32 %0, %1, %2" : "=v"(r) : "v"(lo), "v"(hi)); return r; }

typedef int i32x8 __attribute__((ext_vector_type(8)));
typedef int i32x4 __attribute__((ext_vector_type(4)));
__device__ __forceinline__ i32x8 cat8(bf16x8 lo, bf16x8 hi) { const i32x4 a = __builtin_bit_cast(i32x4, lo), b = __builtin_bit_cast(i32x4, hi); return __builtin_shufflevector(a, b, 0, 1, 2, 3, 4, 5, 6, 7); }
template <int RS, bool F8, class Epi, class Sched, bool ALIGN_EPI>
__device__ __forceinline__ void gemm_phase(LAS unsigned char* lds, const Sched& S, const Epi& E, int wid) {
    int lane_ = lane_now(); asm volatile("" : "+v"(lane_));
    const int lane = lane_, tid = wid * 64 + lane, wr = wid >> 2, wc = wid & 3, fr = lane & 15, fq = lane >> 4;
    constexpr int nt = RS / 128;
    int Rr[2]; unsigned cb[2], voffB[2];
#pragma unroll
    for (int i = 0; i < 2; ++i) { int R, C; stage_rc(tid * 16 + i * 8192, R, C); const int Rb = Epi::ADJ ? (64 * (R >> 5) + perm32(R & 31)) : (Epi::PERM ? ((R & ~31) + perm32(R & 31)) : R);
        Rr[i] = R; cb[i] = (unsigned)C * 2u; voffB[i] = (unsigned)(Rb * RS) + (unsigned)C * 2u; }
    constexpr size_t kstep = (size_t)(BK * 2);
    constexpr size_t hstep = (size_t)(Epi::ADJ ? 32 : HALF) * RS;
    const unsigned ldsw = (unsigned)wid * 1024u;
    const int aoff = lds_byte(wr * 64 + fr, fq * 8), boff = lds_byte(wc * 32 + fr, fq * 8);
#define PG8_SA(b, h) (((b) * 2 + (h)) * HTB)
#define PG8_SB(b, h) ((4 + (b) * 2 + (h)) * HTB)
#define PG8_STAGE(bufoff, gbase, voff) do { _Pragma("unroll") for (int _i = 0; _i < 2; ++_i) \
        __builtin_amdgcn_global_load_lds((const unsigned*)((const char*)(gbase) + (voff)[_i]), (LAS unsigned*)(lds + (bufoff) + ldsw + _i * 8192), 16, 0, 0); } while (0)
#define PG8_LDA(dst, b, h) do { _Pragma("unroll") for (int m = 0; m < 4; ++m) { \
        if constexpr (F8) dst##8[m] = cat8(*(const LAS bf16x8*)(lds + PG8_SA(b, h) + aoff + m * 2048), *(const LAS bf16x8*)(lds + PG8_SA(b, h) + aoff + m * 2048 + 1024)); \
        else { _Pragma("unroll") for (int k = 0; k < 2; ++k) dst[m][k] = *(const LAS bf16x8*)(lds + PG8_SA(b, h) + aoff + m * 2048 + k * 1024); } } } while (0)
#define PG8_LDB(dst, b, h) do { _Pragma("unroll") for (int n = 0; n < 2; ++n) { \
        if constexpr (F8) dst##8[n] = cat8(*(const LAS bf16x8*)(lds + PG8_SB(b, h) + boff + n * 2048), *(const LAS bf16x8*)(lds + PG8_SB(b, h) + boff + n * 2048 + 1024)); \
        else { _Pragma("unroll") for (int k = 0; k < 2; ++k) dst[n][k] = *(const LAS bf16x8*)(lds + PG8_SB(b, h) + boff + n * 2048 + k * 1024); } } } while (0)
#define PG8_MMA(ai, bj, At, Bt) do { __builtin_amdgcn_s_setprio(1); _Pragma("unroll") for (int m = 0; m < 4; ++m) _Pragma("unroll") for (int n = 0; n < 2; ++n) { \
        if constexpr (F8) acc[ai][bj][m][n] = __builtin_amdgcn_mfma_scale_f32_16x16x128_f8f6f4(Bt##8[n], At##8[m], acc[ai][bj][m][n], 0, 0, 0, 0, 0, 0); \
        else { _Pragma("unroll") for (int k = 0; k < 2; ++k) acc[ai][bj][m][n] = __builtin_amdgcn_mfma_f32_16x16x32_bf16(Bt[n][k], At[m][k], acc[ai][bj][m][n], 0, 0, 0); } } \
        __builtin_amdgcn_s_setprio(0); } while (0)
#define PG8_WAIT_V(n) asm volatile("s_waitcnt vmcnt(" #n ")" ::: "memory")
#define PG8_WAIT_L(n) asm volatile("s_waitcnt lgkmcnt(" #n ")" ::: "memory")
#define PG8_BAR __builtin_amdgcn_s_barrier()
#define PG8_SCHED __builtin_amdgcn_sched_barrier(0)
    Unit cur, nxt; int ui = 0;
    if (!S.next(0, cur)) return;
    f32x4 acc[2][2][4][2];
#pragma unroll
    for (int a = 0; a < 2; ++a)
#pragma unroll
        for (int b = 0; b < 2; ++b)
#pragma unroll
            for (int m = 0; m < 4; ++m)
#pragma unroll
                for (int n = 0; n < 2; ++n) acc[a][b][m][n] = (f32x4){0.f, 0.f, 0.f, 0.f};
    bf16x8 At[4][2], B0[2][2], B1[2][2]; i32x8 At8[4], B08[2], B18[2];
    const char* cA = S.a_base(cur); const char* cB = S.b_base(cur);
    unsigned co[2][2], no[2][2];
    S.a_offs(cur, co, Rr, cb);
    PG8_STAGE(PG8_SB(0, 0), cB, voffB); PG8_STAGE(PG8_SB(0, 1), cB + hstep, voffB); PG8_STAGE(PG8_SA(0, 0), cA, co[0]); PG8_STAGE(PG8_SA(0, 1), cA, co[1]);
    if (wr == 1) PG8_BAR;
    PG8_WAIT_V(2); PG8_BAR;
    PG8_STAGE(PG8_SB(1, 0), cB + kstep, voffB); PG8_STAGE(PG8_SA(1, 0), cA + kstep, co[0]); PG8_STAGE(PG8_SB(1, 1), cB + hstep + kstep, voffB);
    PG8_WAIT_V(6); PG8_BAR;
    for (;;) {
        E.prefetch(lds, cur, ui, wid, lane);
        const bool has_next = S.next(ui + 1, nxt);
        const char* nA = has_next ? S.a_base(nxt) : cA; const char* nB = has_next ? S.b_base(nxt) : cB;
        if (has_next) S.a_offs(nxt, no, Rr, cb);
        else {
#pragma unroll
            for (int h = 0; h < 2; ++h)
#pragma unroll
                for (int i = 0; i < 2; ++i) no[h][i] = co[h][i]; }
        const bool fullu = !S.half(cur);
#pragma unroll 1
        for (int t = 0; t < nt; t += 2) {
            const bool last = (t == nt - 2);
            const char* a1 = cA + (size_t)(t + 1) * kstep;
            const char* a2 = last ? nA : cA + (size_t)(t + 2) * kstep; const char* b2 = last ? nB : cB + (size_t)(t + 2) * kstep;
            const char* a3 = a2 + kstep; const char* b3 = b2 + kstep;
            unsigned o2[2][2];
#pragma unroll
            for (int h = 0; h < 2; ++h)
#pragma unroll
                for (int i = 0; i < 2; ++i) o2[h][i] = last ? no[h][i] : co[h][i];
            PG8_LDB(B0, 0, 0); PG8_LDB(B1, 0, 1); PG8_SCHED; PG8_LDA(At, 0, 0); PG8_STAGE(PG8_SA(1, 1), a1, co[1]);
            PG8_WAIT_V(8); PG8_WAIT_L(0); PG8_BAR; PG8_MMA(0, 0, At, B0); PG8_MMA(0, 1, At, B1); PG8_BAR; PG8_SCHED;
            PG8_LDA(At, 0, 1); PG8_STAGE(PG8_SB(0, 0), b2, voffB); PG8_STAGE(PG8_SB(0, 1), b2 + hstep, voffB); PG8_STAGE(PG8_SA(0, 0), a2, o2[0]);
            PG8_WAIT_V(8); PG8_WAIT_L(0); PG8_BAR; if (fullu) { PG8_MMA(1, 0, At, B0); PG8_MMA(1, 1, At, B1); } PG8_BAR; PG8_SCHED;
            PG8_LDB(B0, 1, 0); PG8_LDB(B1, 1, 1); PG8_SCHED; PG8_LDA(At, 1, 0); PG8_STAGE(PG8_SA(0, 1), a2, o2[1]);
            PG8_WAIT_V(8); PG8_WAIT_L(0); PG8_BAR; PG8_MMA(0, 0, At, B0); PG8_MMA(0, 1, At, B1); PG8_BAR; PG8_SCHED;
            PG8_LDA(At, 1, 1); PG8_STAGE(PG8_SB(1, 0), b3, voffB); PG8_STAGE(PG8_SB(1, 1), b3 + hstep, voffB); PG8_STAGE(PG8_SA(1, 0), a3, o2[0]);
            PG8_WAIT_V(8); PG8_WAIT_L(0); PG8_BAR; if (fullu) { PG8_MMA(1, 0, At, B0); PG8_MMA(1, 1, At, B1); } PG8_BAR; PG8_SCHED;
        }
        if constexpr (ALIGN_EPI) { if (wr == 0) PG8_BAR; }
        E(acc, cur, wr, wc, fr, fq, lds, ui);
        if (!has_next) break;
#pragma unroll
        for (int a = 0; a < 2; ++a)
#pragma unroll
            for (int b = 0; b < 2; ++b)
#pragma unroll
                for (int m = 0; m < 4; ++m)
#pragma unroll
                    for (int n = 0; n < 2; ++n) { acc[a][b][m][n] = (f32x4){0.f, 0.f, 0.f, 0.f}; asm volatile("" : "+v"(acc[a][b][m][n])); }
        cur = nxt; cA = nA; cB = nB; ++ui;
#pragma unroll
        for (int h = 0; h < 2; ++h)
#pragma unroll
            for (int i = 0; i < 2; ++i) co[h][i] = no[h][i];
        if constexpr (ALIGN_EPI) { if (wr == 1) PG8_BAR; }
    }
    PG8_WAIT_V(0);
    if constexpr (!ALIGN_EPI) { if (wr == 0) PG8_BAR; }
    PG8_BAR;
#undef PG8_SA
#undef PG8_SB
#undef PG8_STAGE
#undef PG8_LDA
#undef PG8_LDB
#undef PG8_MMA
#undef PG8_WAIT_V
#undef PG8_WAIT_L
#undef PG8_BAR
#undef PG8_SCHED
}

struct EpiBf16 {
    static constexpr bool PERM = true;
    static constexpr bool ADJ = true;
    __device__ __forceinline__ void prefetch(LAS unsigned char*, const Unit&, int, int, int) const {}
    bf16* O; int ldc; float inv;
    __device__ __forceinline__ void operator()(const f32x4 (&acc)[2][2][4][2], const Unit& u, int wr, int wc, int fr, int fq, LAS unsigned char* lds, int ui) const {
        const int row0 = u.pm * BM + wr * 64 + fr, col0 = u.pn * BM + wc * 64 + 8 * fq;
#pragma unroll
        for (int ai = 0; ai < 2; ++ai)
#pragma unroll
            for (int m = 0; m < 4; ++m) { bf16* rowp = O + (size_t)(row0 + ai * HALF + m * 16) * ldc + col0;
#pragma unroll
                for (int bj = 0; bj < 2; ++bj) { const f32x4 v0 = acc[ai][bj][m][0] * inv, v1 = acc[ai][bj][m][1] * inv;
                    u32x4 w; w.x = cvt_pk_bf16(v0[0], v0[1]); w.y = cvt_pk_bf16(v0[2], v0[3]); w.z = cvt_pk_bf16(v1[0], v1[1]); w.w = cvt_pk_bf16(v1[2], v1[3]);
                    *(u32x4*)(rowp + bj * 32) = w; } }
    }
};
struct EpiU {
    static constexpr bool PERM = true;
    static constexpr bool ADJ = true;
    __device__ __forceinline__ void prefetch(LAS unsigned char*, const Unit&, int, int, int) const {}
    bf16* O; const float* rope; float inv;
    __device__ __forceinline__ void operator()(const f32x4 (&acc)[2][2][4][2], const Unit& u, int wr, int wc, int fr, int fq, LAS unsigned char* lds, int ui) const {
        const int row0 = u.pm * BM + wr * 64 + fr, col0 = u.pn * BM + wc * 64 + 8 * fq;
        const bool rot = (u.pn >= 4 && u.pn < 12) && !(u.pm == 0 || u.pm == 17);
        const int axis = wc & 1; const int tb = u.pm >= 17 ? 1 : 0; const int t0 = (u.pm - 1 - 17 * tb) * BM;
#pragma unroll
        for (int bj = 0; bj < 2; ++bj)
#pragma unroll
        for (int mh = 0; mh < 2; ++mh) {
            f32x4 tc[2][2];
            if (rot) { const int c = col0 + bj * 32; const int f0 = (c & 63) >> 1;
#pragma unroll
                for (int k = 0; k < 2; ++k) { const int pos = axis ? (fr + 16 * (2 * mh + k)) : ((t0 >> 6) + wr + 2 * k);
                    const f32x4* cs = (const f32x4*)(rope + ((size_t)pos * 32 + f0) * 2); tc[k][0] = cs[0]; tc[k][1] = cs[1]; } }
#pragma unroll
            for (int ai = 0; ai < 2; ++ai)
#pragma unroll
                for (int mm = 0; mm < 2; ++mm) { const int m = 2 * mh + mm; const int row = row0 + ai * HALF + m * 16; bf16* rowp = O + (size_t)row * NREST + col0;
                    f32x4 v0 = acc[ai][bj][m][0] * inv, v1 = acc[ai][bj][m][1] * inv;
                    if (rot) { f32x4 c01, c23;
#pragma unroll
                        for (int q = 0; q < 4; ++q) { c01[q] = axis ? tc[mm][0][q] : tc[ai][0][q]; c23[q] = axis ? tc[mm][1][q] : tc[ai][1][q]; }
                        f32x4 r0, r1;
                        r0[0] = v0[0] * c01[0] - v0[1] * c01[1]; r0[1] = v0[1] * c01[0] + v0[0] * c01[1];
                        r0[2] = v0[2] * c01[2] - v0[3] * c01[3]; r0[3] = v0[3] * c01[2] + v0[2] * c01[3];
                        r1[0] = v1[0] * c23[0] - v1[1] * c23[1]; r1[1] = v1[1] * c23[0] + v1[0] * c23[1];
                        r1[2] = v1[2] * c23[2] - v1[3] * c23[3]; r1[3] = v1[3] * c23[2] + v1[2] * c23[3];
                        v0 = r0; v1 = r1; }
                    u32x4 w; w.x = cvt_pk_bf16(v0[0], v0[1]); w.y = cvt_pk_bf16(v0[2], v0[3]); w.z = cvt_pk_bf16(v1[0], v1[1]); w.w = cvt_pk_bf16(v1[2], v1[3]);
                    *(u32x4*)(rowp + bj * 32) = w; } }
    }
};
__device__ __forceinline__ f32x4 bf_lo4(unsigned a, unsigned b) { return (f32x4){__uint_as_float(a << 16), __uint_as_float(a & 0xffff0000u), __uint_as_float(b << 16), __uint_as_float(b & 0xffff0000u)}; }
struct EpiOut {
    static constexpr bool PERM = true;
    static constexpr bool ADJ = true;
    __device__ __forceinline__ void prefetch(LAS unsigned char*, const Unit&, int, int, int) const {}
    int l; float inv;
    __device__ __forceinline__ void operator()(const f32x4 (&acc)[2][2][4][2], const Unit& u, int wr, int wc, int fr, int fq, LAS unsigned char* lds, int ui) const {
        const int row0 = u.pm * BM + wr * 64 + fr, col0 = u.pn * BM + wc * 64 + 8 * fq;
        bf16* R = (bf16*)(wsb() + WS_RBUF);
        const float* gr = (const float*)(wsb() + WS_MOD) + (size_t)l * 3 * (6 * DM) + 2 * DM + (size_t)row_mod(u.pm * BM) * (6 * DM) + col0;
        const int tb = u.pm >= 17 ? 1 : 0, tp = (u.pm - 17 * tb) * BM;
        f32x4 gv[2][2];
#pragma unroll
        for (int bj = 0; bj < 2; ++bj)
#pragma unroll
            for (int n = 0; n < 2; ++n) gv[bj][n] = *(const f32x4*)(gr + bj * 32 + n * 4);
#pragma unroll
        for (int ai = 0; ai < 2; ++ai) {
            f32x4 xv[4][2][2];
            if (l) { const bf16* xb = (const bf16*)(wsb() + WS_XB) + (size_t)u.pm * BM * DM;
#pragma unroll
                for (int m = 0; m < 4; ++m)
#pragma unroll
                    for (int bj = 0; bj < 2; ++bj) xv[m][bj][0] = __builtin_bit_cast(f32x4, *(const u32x4*)(xb + (unsigned)((wr * 64 + fr + ai * HALF + m * 16) * DM + col0) + bj * 32));
            } else { const float* xt = (tp < CTXL ? inp(I_CTX) + (size_t)tb * CTXL * DM : inp(I_X) + ((size_t)tb * SEQ + (tp - CTXL)) * DM);
#pragma unroll
                for (int m = 0; m < 4; ++m) { const float* xr = xt + (unsigned)((wr * 64 + fr + ai * HALF + m * 16) * DM + col0);
#pragma unroll
                    for (int bj = 0; bj < 2; ++bj)
#pragma unroll
                        for (int n = 0; n < 2; ++n) xv[m][bj][n] = *(const f32x4*)(xr + bj * 32 + n * 4); } }
#pragma unroll
            for (int m = 0; m < 4; ++m) { const int row = row0 + ai * HALF + m * 16; bf16* rowp = R + (size_t)row * DM + col0;
#pragma unroll
                for (int bj = 0; bj < 2; ++bj) { f32x4 x0, x1;
                    if (l) { const u32x4 raw = __builtin_bit_cast(u32x4, xv[m][bj][0]); x0 = bf_lo4(raw.x, raw.y); x1 = bf_lo4(raw.z, raw.w); } else { x0 = xv[m][bj][0]; x1 = xv[m][bj][1]; }
                    const f32x4 v0 = x0 * ALPHA + gv[bj][0] * (acc[ai][bj][m][0] * inv), v1 = x1 * ALPHA + gv[bj][1] * (acc[ai][bj][m][1] * inv);
                    u32x4 w; w.x = cvt_pk_bf16(v0[0], v0[1]); w.y = cvt_pk_bf16(v0[2], v0[3]); w.z = cvt_pk_bf16(v1[0], v1[1]); w.w = cvt_pk_bf16(v1[2], v1[3]);
                    *(u32x4*)(rowp + bj * 32) = w; } } }
    }
};
struct EpiMoe1 {
    static constexpr bool PERM = true;
    static constexpr bool ADJ = false;
    __device__ __forceinline__ void prefetch(LAS unsigned char*, const Unit&, int, int, int) const {}
    unsigned char* ACT; float inv;
    __device__ __forceinline__ void operator()(const f32x4 (&acc)[2][2][4][2], const Unit& u, int wr, int wc, int fr, int fq, LAS unsigned char* lds, int ui) const {
        const int row0 = u.pm * BM + wr * 64 + fr, col0 = u.pn * HALF + wc * 32 + 8 * fq;
#pragma unroll
        for (int ai = 0; ai < 2; ++ai)
#pragma unroll
            for (int m = 0; m < 4; ++m) { unsigned char* rowp = ACT + (size_t)(row0 + ai * HALF + m * 16) * DEXP + col0;
                const f32x4 g0 = acc[ai][0][m][0] * inv, g1 = acc[ai][0][m][1] * inv, u0 = acc[ai][1][m][0] * inv, u1 = acc[ai][1][m][1] * inv;
                float a[8];
#pragma unroll
                for (int j = 0; j < 4; ++j) { a[j] = silu_f(g0[j]) * u0[j]; a[4 + j] = silu_f(g1[j]) * u1[j]; }
                int w0 = 0, w1 = 0;
                w0 = cvt2_fp8(a[0], a[1], w0, false); w0 = cvt2_fp8(a[2], a[3], w0, true);
                w1 = cvt2_fp8(a[4], a[5], w1, false); w1 = cvt2_fp8(a[6], a[7], w1, true);
                *(u32x2*)rowp = (u32x2){(unsigned)w0, (unsigned)w1}; }
    }
};
__device__ __forceinline__ int shared_row(int lr, int latent_only) { return latent_only ? (lr < SEQ ? CTXL + lr : RB + CTXL + (lr - SEQ)) : lr; }
struct EpiMoe2 {
    static constexpr bool PERM = true;
    static constexpr bool ADJ = true;
    static constexpr int LISTOFF = 131072;
    __device__ __forceinline__ void prefetch(LAS unsigned char* lds, const Unit& u, int ui, int wid, int lane) const {
        if (u.e != NEXP) { const int* src = (wid < 4 ? ldst : lw) + (size_t)u.e * LCAP + u.rt * BM + (wid & 3) * 64 + lane;
            __builtin_amdgcn_global_load_lds((const unsigned*)src, (LAS unsigned*)(lds + LISTOFF + (ui & 1) * 2048 + (wid >> 2) * 1024 + (wid & 3) * 256), 4, 0, 0); }
    }
    bf16* YG; const int* ldst; const int* lw; const volatile LAS int* cnt; int latent_only; float inv; int nostore;
    __device__ __forceinline__ void operator()(const f32x4 (&acc)[2][2][4][2], const Unit& u, int wr, int wc, int fr, int fq, LAS unsigned char* lds, int ui) const {
        const int r0 = wr * 64 + fr, col0 = u.pn * BM + wc * 64 + 8 * fq;
        const bool shared = (u.e == NEXP); const int nvalid = shared ? (latent_only ? NB * SEQ : M) : __builtin_amdgcn_readfirstlane(cnt[u.e]);
#pragma unroll
        for (int ai = 0; ai < 2; ++ai) {
            int dst[4]; float w[4];
            if (shared) {
#pragma unroll
                for (int m = 0; m < 4; ++m) { const int lr = u.rt * BM + r0 + ai * HALF + m * 16; dst[m] = shared_row(lr, latent_only) * 9 + 8; w[m] = inv; }
            } else { const LAS int* L = (const LAS int*)(lds + LISTOFF + (ui & 1) * 2048);
#pragma unroll
                for (int m = 0; m < 4; ++m) { const int r = r0 + ai * HALF + m * 16; dst[m] = L[r]; w[m] = __int_as_float(L[256 + r]) * inv; }
            }
            if (nostore == 2) {
#pragma unroll
                for (int m = 0; m < 4; ++m) dst[m] = u.pm * 256 + r0 + ai * HALF + m * 16; }
            if (nostore == 3) {
#pragma unroll
                for (int m = 0; m < 4; ++m) dst[m] = r0 + ai * HALF + m * 16; }
#pragma unroll
            for (int m = 0; m < 4; ++m) { const int lr = u.rt * BM + r0 + ai * HALF + m * 16;
                if ((lr < nvalid && !nostore) || nostore >= 2) {
                    bf16* rowp = (nostore == 3 ? (bf16*)(wsb() + WS_U) : YG) + (size_t)dst[m] * DM + col0; const float ws_ = w[m];
#pragma unroll
                    for (int bj = 0; bj < 2; ++bj) { const f32x4 v0 = acc[ai][bj][m][0] * ws_, v1 = acc[ai][bj][m][1] * ws_;
                        u32x4 o; o.x = cvt_pk_bf16(v0[0], v0[1]); o.y = cvt_pk_bf16(v0[2], v0[3]); o.z = cvt_pk_bf16(v1[0], v1[1]); o.w = cvt_pk_bf16(v1[2], v1[3]);
                        *(u32x4*)(rowp + bj * 32) = o; } } } }
    }
};

template <int RS, int NTN, bool GATHER> struct MoeSched {
    const volatile LAS int* tpre; const volatile LAS int* fpre; int G, c;
    const unsigned char* A; const unsigned char* Bt;
    const int* ltok; const volatile LAS int* cnt; int latent_only;
    __device__ bool next(int i, Unit& u) const {
#define RFL(v) __builtin_amdgcn_readfirstlane(v)
        const int L = i * G + c; const int nfull = RFL(fpre[NEX1]), ntail = RFL(fpre[NEX1 + 1]);
        if (L >= (nfull + ntail) * NTN) return false;
        int ti = L / NTN; u.pn = L % NTN; int e;
        if (ti < nfull) { int lo = 0, hi = NEX1;
            while (hi - lo > 1) { const int mid = (lo + hi) >> 1; if (RFL(fpre[mid]) <= ti) lo = mid; else hi = mid; }
            e = lo; u.rt = ti - RFL(fpre[e]); }
        else { e = RFL(fpre[NEX1 + 2 + (ti - nfull)]); u.rt = RFL(tpre[e + 1]) - RFL(tpre[e]) - 1; }
        u.e = e; u.pm = RFL(tpre[e]) + u.rt; return true;
#undef RFL
    }
    __device__ __forceinline__ bool half(const Unit& u) const { const int nvalid = (u.e == NEXP) ? (latent_only ? NB * SEQ : M) : __builtin_amdgcn_readfirstlane(cnt[u.e]); return nvalid - u.rt * 256 <= HALF; }
    __device__ __forceinline__ const char* a_base(const Unit& u) const { return GATHER ? (const char*)A : (const char*)A + (size_t)u.pm * 256 * RS; }
    __device__ __forceinline__ const char* b_base(const Unit& u) const { return (const char*)Bt + ((size_t)u.e * (NTN * 256) + (size_t)u.pn * 256) * RS; }
    __device__ __forceinline__ void a_offs(const Unit& u, unsigned (&o)[2][2], const int (&R)[2], const unsigned (&cb)[2]) const {
        if constexpr (GATHER) {
            const bool shared = (u.e == NEXP); const int nvalid = shared ? (latent_only ? NB * SEQ : M) : __builtin_amdgcn_readfirstlane(cnt[u.e]);
            int tok[2][2];
            if (shared) {
#pragma unroll
                for (int h = 0; h < 2; ++h)
#pragma unroll
                    for (int i = 0; i < 2; ++i) { const int lr = u.rt * 256 + h * HALF + R[i]; tok[h][i] = shared_row(lr < nvalid ? lr : 0, latent_only); }
            } else {
                const int* lp = ltok + (size_t)u.e * LCAP;
#pragma unroll
                for (int h = 0; h < 2; ++h)
#pragma unroll
                    for (int i = 0; i < 2; ++i) { const int lr = u.rt * 256 + h * HALF + R[i]; tok[h][i] = lp[lr < nvalid ? lr : 0]; }
#pragma unroll
                for (int h = 0; h < 2; ++h)
#pragma unroll
                    for (int i = 0; i < 2; ++i) { const int lr = u.rt * 256 + h * HALF + R[i]; tok[h][i] = lr < nvalid ? tok[h][i] : CTXL; }
            }
#pragma unroll
            for (int h = 0; h < 2; ++h)
#pragma unroll
                for (int i = 0; i < 2; ++i) o[h][i] = (unsigned)tok[h][i] * (unsigned)RS + cb[i];
        } else {
#pragma unroll
            for (int h = 0; h < 2; ++h)
#pragma unroll
                for (int i = 0; i < 2; ++i) o[h][i] = (unsigned)((h * HALF + R[i]) * RS) + cb[i];
        }
    }
};
}

namespace att {
constexpr int D = 128, NW = 8, QBLK = 32, KVBLK = 64;
constexpr float SCALE = 0.088388347648318440f;
constexpr float THR = 8.f;
constexpr int SDEPTH = 2;
constexpr size_t SHM_V = KVBLK * D * 2, SHM_K = KVBLK * D * 2, SHM_ATTN = 2 * SHM_V + 2 * SHM_K + NW * 64 * 4;
#define KSWZ(row, colB) ((row) * 256 + ((colB) ^ (((row) & 7) << 4)))
#define SBAR() __builtin_amdgcn_sched_barrier(0)
__device__ __forceinline__ int crow(int r, int hi) { return (r & 3) + 8 * (r >> 2) + 4 * hi; }
__device__ __forceinline__ unsigned cvtpk(float lo, float hi) { unsigned r; asm volatile("v_cvt_pk_bf16_f32 %0, %1, %2" : "=v"(r) : "v"(lo), "v"(hi)); return r; }
__device__ __forceinline__ bf16x8 ld8(const bf16* p) { return *reinterpret_cast<const bf16x8*>(p); }

__device__ __forceinline__ void partialSM(f32x16& p0, f32x16& p1, float& m_reg, float& mn, float& alpha) {
  constexpr float C = SCALE * 1.4426950408889634f;
  float pmax = p0[0]; for (int r = 1; r < 16; ++r) pmax = fmaxf(pmax, p0[r]); for (int r = 0; r < 16; ++r) pmax = fmaxf(pmax, p1[r]);
  { auto rr = __builtin_amdgcn_permlane32_swap(__float_as_uint(pmax), __float_as_uint(pmax), false, false);
    pmax = fmaxf(__uint_as_float(rr[0]), __uint_as_float(rr[1])); }
  if (__builtin_expect(__all(pmax - m_reg <= THR / SCALE), 1)) { mn = m_reg; alpha = 1.f; }
  else { mn = fmaxf(m_reg, pmax); alpha = __builtin_amdgcn_exp2f((m_reg - mn) * C); m_reg = mn; }
  float mnC = -mn * C;
  for (int r = 0; r < 16; ++r) p0[r] = fmaf(p0[r], C, mnC); for (int r = 0; r < 16; ++r) p1[r] = fmaf(p1[r], C, mnC);
  for (int r = 0; r < 16; ++r) p0[r] = __builtin_amdgcn_exp2f(p0[r]);
}
__device__ __forceinline__ void finishSM(f32x16& p0, f32x16& p1, float alpha, float& l_reg, bf16x8& pa0, bf16x8& pa1, bf16x8& pa2, bf16x8& pa3) {
  for (int r = 0; r < 16; ++r) p1[r] = __builtin_amdgcn_exp2f(p1[r]);
  float ps = 0; for (int r = 0; r < 16; ++r) ps += p0[r]; for (int r = 0; r < 16; ++r) ps += p1[r];
  { auto rr = __builtin_amdgcn_permlane32_swap(__float_as_uint(ps), __float_as_uint(ps), false, false);
    ps = __uint_as_float(rr[0]) + __uint_as_float(rr[1]); }
  l_reg = l_reg * alpha + ps;
#define PK4(P, BASE, OUT) do { unsigned a0 = cvtpk(P[BASE + 0], P[BASE + 1]), a1 = cvtpk(P[BASE + 2], P[BASE + 3]);   \
    unsigned b0 = cvtpk(P[BASE + 4], P[BASE + 5]), b1 = cvtpk(P[BASE + 6], P[BASE + 7]);                              \
    auto r0 = __builtin_amdgcn_permlane32_swap(a0, b0, false, false); auto r1 = __builtin_amdgcn_permlane32_swap(a1, b1, false, false); \
    u32x4 w = {r0[0], r1[0], r0[1], r1[1]}; OUT = *reinterpret_cast<bf16x8*>(&w); } while (0)
  PK4(p0, 0, pa0); PK4(p0, 8, pa1); PK4(p1, 0, pa2); PK4(p1, 8, pa3);
#undef PK4
}
__device__ __forceinline__ void qkt(f32x16& p0, f32x16& p1, const bf16* Ks, const bf16x8* qr, int r32, int hi) {
  p0 = f32x16{}; p1 = f32x16{};
  for (int d0 = 0; d0 < 8; ++d0) { int cb = (d0 * 16 + hi * 8) * 2;
    bf16x8 b0 = *reinterpret_cast<const bf16x8*>((const char*)Ks + KSWZ(r32, cb));
    bf16x8 b1 = *reinterpret_cast<const bf16x8*>((const char*)Ks + KSWZ(32 + r32, cb));
    p0 = __builtin_amdgcn_mfma_f32_32x32x16_bf16(b0, qr[d0], p0, 0, 0, 0);
    p1 = __builtin_amdgcn_mfma_f32_32x32x16_bf16(b1, qr[d0], p1, 0, 0, 0); }
}
__device__ __forceinline__ int v_st(int k, int c) { const int kk = (k & ~0xC) | ((k & 4) << 1) | ((k & 8) >> 1); return ((kk >> 3) * 4 + (c >> 5)) * 512 + ((kk & 7) * 32 + (c & 31)) * 2; }
__device__ __forceinline__ int v_rd_base(int lane) { return ((lane & 3) << 3) | (((lane >> 2) & 3) << 6) | (((lane >> 4) & 1) << 5) | (((lane >> 5) & 1) << 8); }
constexpr int v_rd_off(int d0, int ks, int half) { return d0 * 512 + ks * 4096 + half * 2048; }
template <int OFF> __device__ __forceinline__ s16x4 tr_read(int vb) {
  s16x4 r; asm volatile("ds_read_b64_tr_b16 %0, %1 offset:%2" : "=&v"(r) : "v"(vb), "i"(OFF) : "memory"); return r;
}
template <int D0> __device__ __forceinline__ void pv_one(f32x16& od, int vb, bf16x8 pa0, bf16x8 pa1, bf16x8 pa2, bf16x8 pa3) {
  const s16x4 l0 = tr_read<v_rd_off(D0, 0, 0)>(vb), h0 = tr_read<v_rd_off(D0, 0, 1)>(vb), l1 = tr_read<v_rd_off(D0, 1, 0)>(vb), h1 = tr_read<v_rd_off(D0, 1, 1)>(vb);
  const s16x4 l2 = tr_read<v_rd_off(D0, 2, 0)>(vb), h2 = tr_read<v_rd_off(D0, 2, 1)>(vb), l3 = tr_read<v_rd_off(D0, 3, 0)>(vb), h3 = tr_read<v_rd_off(D0, 3, 1)>(vb);
  asm volatile("s_waitcnt lgkmcnt(0)" ::: "memory"); SBAR();
#define PK(L, H) (bf16x8){L[0], L[1], L[2], L[3], H[0], H[1], H[2], H[3]}
  od = __builtin_amdgcn_mfma_f32_32x32x16_bf16(pa0, PK(l0, h0), od, 0, 0, 0);
  od = __builtin_amdgcn_mfma_f32_32x32x16_bf16(pa1, PK(l1, h1), od, 0, 0, 0);
  od = __builtin_amdgcn_mfma_f32_32x32x16_bf16(pa2, PK(l2, h2), od, 0, 0, 0);
  od = __builtin_amdgcn_mfma_f32_32x32x16_bf16(pa3, PK(l3, h3), od, 0, 0, 0);
#undef PK
}
__device__ __forceinline__ void pv_d0(f32x16* o, int vb, bf16x8 pa0, bf16x8 pa1, bf16x8 pa2, bf16x8 pa3) {
  pv_one<0>(o[0], vb, pa0, pa1, pa2, pa3); pv_one<1>(o[1], vb, pa0, pa1, pa2, pa3); pv_one<2>(o[2], vb, pa0, pa1, pa2, pa3); pv_one<3>(o[3], vb, pa0, pa1, pa2, pa3);
}
template <int LDQ, int LDK, int LDO>
__device__ __forceinline__ void attn_dense_body(const bf16* __restrict__ Qb, const bf16* __restrict__ Kh, const bf16* __restrict__ Vh, float* __restrict__ Ob, int seq, char* lds, int wid) {
  int lane_ = lane_now(); asm volatile("" : "+v"(lane_));
  const int lane = lane_, tid = wid * 64 + lane, r32 = lane & 31, hi = lane >> 5;
  bf16* V_lds = (bf16*)lds; bf16* K_lds = (bf16*)(lds + 2 * SHM_V);
  float* ws = (float*)(lds + 2 * SHM_V + 2 * SHM_K) + wid * 64; float* li_l = ws; float* al_l = ws + 32;
  float m_reg = -1e30f, l_reg = 0; f32x16 o[4] = {}; bf16x8 qr[8];
  const bf16* Qw = Qb + (long)(wid * QBLK + r32) * LDQ + hi * 8;
#pragma unroll
  for (int d0 = 0; d0 < 8; ++d0) qr[d0] = ld8(Qw + d0 * 16);
  const int sr = tid >> 4, sc = (tid & 15) * 8, vst0 = v_st(sr, sc), vst1 = v_st(32 + sr, sc);
  const int vb0 = (int)(uintptr_t)V_lds + v_rd_base(lane);
  struct { bf16x8 vs0, vs1, ks0, ks1; } sr_[SDEPTH];
#define SLOAD(i, k0) do { sr_[i].vs0 = ld8(&Vh[(long)((k0) + sr) * LDK + sc]); sr_[i].vs1 = ld8(&Vh[(long)((k0) + 32 + sr) * LDK + sc]); \
    sr_[i].ks0 = ld8(&Kh[(long)((k0) + sr) * LDK + sc]); sr_[i].ks1 = ld8(&Kh[(long)((k0) + 32 + sr) * LDK + sc]); } while (0)
#define SWRITE(b, i) do { *(bf16x8*)((char*)V_lds + (b) * SHM_V + vst0) = sr_[i].vs0;          \
    *(bf16x8*)((char*)V_lds + (b) * SHM_V + vst1) = sr_[i].vs1; int kc = sc * 2;               \
    *(bf16x8*)((char*)K_lds + (b) * SHM_K + KSWZ(sr, kc)) = sr_[i].ks0;                       \
    *(bf16x8*)((char*)K_lds + (b) * SHM_K + KSWZ(32 + sr, kc)) = sr_[i].ks1; } while (0)
#define SWAIT() do { asm volatile("s_waitcnt vmcnt(4)" ::: "memory"); } while (0)
#define RESC(a) do { if (__any((a) < 1.f)) { if (hi == 0) al_l[r32] = (a); asm volatile("s_waitcnt lgkmcnt(0)" ::: "memory"); \
    for (int d = 0; d < 4; ++d) for (int r = 0; r < 16; ++r) o[d][r] *= al_l[crow(r, hi)]; } } while (0)
  f32x16 pA0, pA1, pB0, pB1; float mnA, mnB, alA, alB; bf16x8 pa0, pa1, pa2, pa3; const int NT = seq / KVBLK;
  constexpr int SE = 0, SO = SDEPTH - 1;
  SLOAD(SE, 0); asm volatile("s_waitcnt vmcnt(0)" ::: "memory"); SWRITE(0, SE); __syncthreads();
  qkt(pA0, pA1, K_lds, qr, r32, hi); partialSM(pA0, pA1, m_reg, mnA, alA);
  SLOAD(SO, KVBLK); if (2 < NT) SLOAD(SE, 2 * KVBLK);
  SWAIT(); SWRITE(1, SO); __syncthreads();
  for (int j = 1; j + 1 < NT; j += 2) {
    SBAR(); qkt(pB0, pB1, (bf16*)((char*)K_lds + SHM_K), qr, r32, hi);
    finishSM(pA0, pA1, alA, l_reg, pa0, pa1, pa2, pa3); SBAR();
    SLOAD(SO, (j + SDEPTH) * KVBLK); SBAR();
    pv_d0(o, vb0, pa0, pa1, pa2, pa3); partialSM(pB0, pB1, m_reg, mnB, alB);
    __syncthreads(); SWAIT(); SWRITE(0, SE);
    RESC(alB); __syncthreads();
    SBAR(); qkt(pA0, pA1, K_lds, qr, r32, hi);
    finishSM(pB0, pB1, alB, l_reg, pa0, pa1, pa2, pa3); SBAR();
    if (j + 3 < NT) SLOAD(SE, (j + 1 + SDEPTH) * KVBLK); SBAR();
    pv_d0(o, vb0 + (int)SHM_V, pa0, pa1, pa2, pa3); partialSM(pA0, pA1, m_reg, mnA, alA);
    __syncthreads(); SWAIT(); SWRITE(1, SO);
    RESC(alA); __syncthreads();
  }
  SBAR(); qkt(pB0, pB1, (bf16*)((char*)K_lds + SHM_K), qr, r32, hi);
  finishSM(pA0, pA1, alA, l_reg, pa0, pa1, pa2, pa3); SBAR();
  pv_d0(o, vb0, pa0, pa1, pa2, pa3); partialSM(pB0, pB1, m_reg, mnB, alB);
  __syncthreads(); RESC(alB);
  finishSM(pB0, pB1, alB, l_reg, pa0, pa1, pa2, pa3); SBAR();
  pv_d0(o, vb0 + (int)SHM_V, pa0, pa1, pa2, pa3);
  if (hi == 0) li_l[r32] = l_reg; asm volatile("s_waitcnt lgkmcnt(0)" ::: "memory");
  float rli[16];
#pragma unroll
  for (int r = 0; r < 16; ++r) rli[r] = __builtin_amdgcn_rcpf(li_l[crow(r, hi)]);
  float* Ow = Ob + (long)(wid * QBLK) * LDO;
#pragma unroll
  for (int r = 0; r < 16; ++r) { int orow = crow(r, hi);
    for (int d0 = 0; d0 < 4; ++d0) Ow[(long)orow * LDO + d0 * 32 + r32] = o[d0][r] * rli[r]; }
  __syncthreads();
#undef SLOAD
#undef SWRITE
#undef SWAIT
#undef RESC
}
#undef KSWZ
#undef SBAR
}

struct Args { const float* in[36]; float* out; unsigned char* ws; int ph_lo, ph_hi, li, pad; };
__device__ __forceinline__ int rowmap(int mode, int n) {
    if (mode == 1) { if (n >= 2560 && n < 4608) return (n & ~63) + 2 * (n & 31) + ((n >> 5) & 1); return n; }
    if (mode == 2) return (n >> 7) * 256 + (n & 127);
    if (mode == 3) return (n >> 7) * 256 + 128 + (n & 127);
    return n;
}
__device__ __forceinline__ void tr_tile(const float* __restrict__ W, int ldn, int k0, int n0, bf16* __restrict__ WT, int Kd, int mode, LAS float* scr, int lane) {
    f32x4 v[16];
    const float* src = W + (size_t)(k0 + (lane >> 4)) * ldn + n0 + (lane & 15) * 4;
#pragma unroll
    for (int i = 0; i < 16; ++i) v[i] = __builtin_nontemporal_load((const f32x4*)(src + (size_t)(4 * i) * ldn));
#pragma unroll
    for (int i = 0; i < 16; ++i) { LAS float* d = scr + (4 * i + (lane >> 4)) * 65 + (lane & 15) * 4; d[0] = v[i][0]; d[1] = v[i][1]; d[2] = v[i][2]; d[3] = v[i][3]; }
    LDS_WAIT();
    const int c = lane >> 3, nn = lane & 7;
#pragma unroll
    for (int j = 0; j < 8; ++j) { const int n = nn + 8 * j; const LAS float* s = scr + (8 * c) * 65 + n;
        u32x4 o; o.x = pk_bf16(s[0], s[65]); o.y = pk_bf16(s[130], s[195]); o.z = pk_bf16(s[260], s[325]); o.w = pk_bf16(s[390], s[455]);
        *(u32x4*)(WT + (size_t)rowmap(mode, n0 + n) * Kd + k0 + 8 * c) = o; }
    LDS_WAIT();
}
constexpr float W8_SCALE = 64.0f;
__device__ __forceinline__ void cvt_store8(const f32x4 (&v)[16], unsigned char* __restrict__ dstk, int Kd, int mode, int n0, int lane) {
    const int r = lane >> 3, c = lane & 7;
#pragma unroll
    for (int j = 0; j < 4; ++j) { int w[4];
#pragma unroll
        for (int q = 0; q < 4; ++q) { int t = 0; t = __builtin_amdgcn_cvt_pk_fp8_f32(v[4 * q][j] * W8_SCALE, v[4 * q + 1][j] * W8_SCALE, t, false);
            t = __builtin_amdgcn_cvt_pk_fp8_f32(v[4 * q + 2][j] * W8_SCALE, v[4 * q + 3][j] * W8_SCALE, t, true); w[q] = t; }
        __builtin_nontemporal_store((u32x4){(unsigned)w[0], (unsigned)w[1], (unsigned)w[2], (unsigned)w[3]}, (u32x4*)(dstk + (size_t)rowmap(mode, n0 + 4 * c + j) * Kd + 16 * r)); }
}
__device__ __forceinline__ void tr_tile8(const float* __restrict__ W, int ldn, int k0, int n0, unsigned char* __restrict__ WT, int Kd, int mode, LAS float* scr, int lane) {
    f32x4 v[16];
    const float* src = W + (size_t)(k0 + 16 * (lane >> 3)) * ldn + n0 + (lane & 7) * 4;
#pragma unroll
    for (int i = 0; i < 16; ++i) v[i] = __builtin_nontemporal_load((const f32x4*)(src + (size_t)i * ldn));
    cvt_store8(v, WT + k0, Kd, mode, n0, lane);
}
constexpr int TI_WIN = 32 * 88, TI_WOUT = 32 * 32, TI_EXP = 256;
constexpr int TI_W3 = 32;
constexpr int TI_LAYER = TI_WIN + TI_WOUT + TI_W3;
constexpr int TI_MOE = 3 * NEX1 * TI_EXP;
__device__ __forceinline__ void tr_item(const Args& a, int it, LAS float* scr, int lane) {
    const int l = it / TI_LAYER; int r = it % TI_LAYER; unsigned char* ws = wsb();
    if (r < TI_W3) { tr_tile(inp(I_HYW3) + (size_t)l * 64 * 2048, 2048, 0, r * 64, (bf16*)(ws + WS_W3T) + (size_t)l * 2048 * 64, 64, 0, scr, lane); return; }
    r -= TI_W3;
    if (r < TI_WIN) {
#if FP8_IN
        const int kb = r / 176, nb = r % 176; tr_tile8(inp(I_WIN) + (size_t)l * DM * DIN, DIN, kb * 128, nb * 32, ws + WS_WINT + (size_t)l * DIN * DM, DM, 1, scr, lane); return; }
#else
        const int kb = r / 88, nb = r % 88; tr_tile(inp(I_WIN) + (size_t)l * DM * DIN, DIN, kb * 64, nb * 64, (bf16*)(ws + WS_WINT) + (size_t)l * DIN * DM, DM, 1, scr, lane); return; }
#endif
    r -= TI_WIN;
    {
#if FP8_OUT
        const int kb = r / 64, nb = r % 64; tr_tile8(inp(I_WOUT) + (size_t)l * DM * DM, DM, kb * 128, nb * 32, ws + WS_WOUTT + (size_t)l * DM * DM, DM, 0, scr, lane); return; }
#else
        const int kb = r / 32, nb = r % 32; tr_tile(inp(I_WOUT) + (size_t)l * DM * DM, DM, kb * 64, nb * 64, (bf16*)(ws + WS_WOUTT) + (size_t)l * DM * DM, DM, 0, scr, lane); return; }
#endif
}
struct MoeTile { const float* src; int ldn; unsigned char* dst; int Kd; int mode; int n0; };
__device__ __forceinline__ MoeTile moe_tile(int l, int r) {
    MoeTile m; unsigned char* ws = wsb();
    const int kind = r / (NEX1 * TI_EXP); r %= (NEX1 * TI_EXP); const int e = r / TI_EXP, t = r % TI_EXP;
    if (kind < 2) {
        const float* W = (e < NEXP) ? inp(kind == 0 ? I_EWG : I_EWU) + ((size_t)l * NEXP + e) * DM * DEXP : inp(kind == 0 ? I_SWG : I_SWU) + (size_t)l * DM * DEXP;
        const int kb = t / 16, nb = t % 16;
        m.src = W + (size_t)(kb * 128) * DEXP + nb * 32; m.ldn = DEXP; m.dst = ws + WS_W1T + ((size_t)l * NEX1 + e) * 1024 * DM + kb * 128; m.Kd = DM; m.mode = 2 + kind; m.n0 = nb * 32;
    } else {
        const float* W = (e < NEXP) ? inp(I_EWD) + ((size_t)l * NEXP + e) * DEXP * DM : inp(I_SWD) + (size_t)l * DEXP * DM;
        const int kb = t / 64, nb = t % 64;
        m.src = W + (size_t)(kb * 128) * DM + nb * 32; m.ldn = DM; m.dst = ws + WS_W2T + ((size_t)l * NEX1 + e) * DM * DEXP + kb * 128; m.Kd = DEXP; m.mode = 0; m.n0 = nb * 32;
    }
    return m;
}
#define MOE_LOAD(dstv, tile) do { const MoeTile m_ = moe_tile(l, (tile)); const float* src_ = m_.src + (size_t)(16 * (lane >> 3)) * m_.ldn + (lane & 7) * 4; \
        _Pragma("unroll") for (int i = 0; i < 16; ++i) dstv[i] = __builtin_nontemporal_load((const f32x4*)(src_ + (size_t)i * m_.ldn)); } while (0)
#define MOE_PUT(srcv, tile) do { const MoeTile m_ = moe_tile(l, (tile)); cvt_store8(srcv, m_.dst, m_.Kd, m_.mode, m_.n0, lane); } while (0)
__device__ __forceinline__ void moe_conv_range(int l, int it, const int stride, const int end, int lane) {
    f32x4 va[16], vb[16];
    if (it >= end) return;
    MOE_LOAD(va, it);
    for (;;) {
        {   const int nx = (it + stride < end) ? it + stride : it; MOE_LOAD(vb, nx); }
        MOE_PUT(va, it);
        it += stride; if (it >= end) break;
        {   const int nx = (it + stride < end) ? it + stride : it; MOE_LOAD(va, nx); }
        MOE_PUT(vb, it);
        it += stride; if (it >= end) break;
    }
}
__device__ __forceinline__ void moe_conv(int l, LAS unsigned char* lds, int G, int bid, int wave, int lane) {
    asm volatile("" : "+v"(lane));
    const int NGW = G * NWAVES, gw = bid * NWAVES + wave;
    const int def = (G > 64) ? ((l == NLAYER - 1) ? 6 : 9) : 0;
    const int a = (TI_MOE - 32 * NWAVES * 0) / NGW;
    const int n1 = (a - def) * NGW;
    moe_conv_range(l, gw, NGW, n1, lane);
    if (def == 0) moe_conv_range(l, n1 + gw, NGW, TI_MOE, lane);
    else if (bid >= 32) moe_conv_range(l, n1 + (bid - 32) * NWAVES + wave, (G - 32) * NWAVES, TI_MOE, lane);
}
__device__ __forceinline__ void ada_unit(const Args& a, int u, LAS unsigned char* lds, int tid, int wave, int lane) {
    const int l = u / 96, cbk = u % 96;
    LAS float* sv = (LAS float*)lds; LAS float* red = sv + 3 * DM;
    for (int i = tid; i < 3 * DM; i += NTHR) { const int r = i / DM, k = i % DM; const float cv = (r < 2) ? inp(I_C)[r * DM + k] : inp(I_CCTX)[k]; sv[i] = silu_f(cv); }
    __syncthreads();
    const float* W = inp(I_ADAW) + (size_t)l * DM * (6 * DM) + cbk * 128 + (lane & 31) * 4;
    f32x4 acc0 = {0.f, 0.f, 0.f, 0.f}, acc1 = acc0, acc2 = acc0;
    const int kb = wave * 256 + (lane >> 5);
#pragma unroll 8
    for (int i = 0; i < 128; ++i) { const int k = kb + 2 * i; const f32x4 w = __builtin_nontemporal_load((const f32x4*)(W + (size_t)k * (6 * DM)));
        acc0 += w * sv[k]; acc1 += w * sv[DM + k]; acc2 += w * sv[2 * DM + k]; }
#pragma unroll
    for (int j = 0; j < 4; ++j) { acc0[j] += __shfl_xor(acc0[j], 32); acc1[j] += __shfl_xor(acc1[j], 32); acc2[j] += __shfl_xor(acc2[j], 32); }
    if (lane < 32) {
#pragma unroll
        for (int j = 0; j < 4; ++j) { red[(wave * 3 + 0) * 128 + lane * 4 + j] = acc0[j]; red[(wave * 3 + 1) * 128 + lane * 4 + j] = acc1[j]; red[(wave * 3 + 2) * 128 + lane * 4 + j] = acc2[j]; } }
    __syncthreads();
    if (tid < 384) { const int r = tid / 128, cc = tid % 128; float s = inp(I_ADAB)[(size_t)l * 6 * DM + cbk * 128 + cc];
#pragma unroll
        for (int w = 0; w < 8; ++w) s += red[(w * 3 + r) * 128 + cc];
        ((float*)(wsb() + WS_MOD))[((size_t)l * 3 + r) * (6 * DM) + cbk * 128 + cc] = s; }
    __syncthreads();
}
__device__ __forceinline__ void hid_item(const Args& a, int it, int lane) {
    int l, n, pos; bf16* out;
    if (it < NLAYER * SEQ) { l = it / SEQ; pos = it % SEQ; n = SEQ; out = (bf16*)(wsb() + WS_HIDB) + ((size_t)l * RB + pos) * 64; }
    else { const int r = it - NLAYER * SEQ; l = r / CTXL; pos = r % CTXL; n = CTXL; out = (bf16*)(wsb() + WS_HIDB) + ((size_t)l * RB + SEQ + pos) * 64; }
    const float* w1 = inp(I_HYW1) + (size_t)l * 17 * 64; const float* w2 = inp(I_HYW2) + (size_t)l * 64 * 64;
    const float fq = inp(I_HYFREQ)[l * 64 + lane];
    const float tt = (float)pos / (float)(n - 1);
    float pre = inp(I_HYB1)[l * 64 + lane] + tt * w1[lane];
#pragma unroll
    for (int i = 0; i < 8; ++i) { const float band = 1e-4f + (float)i * ((7.0f - 1e-4f) / 7.0f); float rev = ((float)pos * band) / (float)n; rev -= floorf(rev);
        const float cs = __builtin_amdgcn_cosf(rev), sn = __builtin_amdgcn_sinf(rev);
        pre += cs * w1[(1 + i) * 64 + lane] - sn * w1[(9 + i) * 64 + lane]; }
    const float h1 = sin_rad(fq * pre);
    float pre2 = inp(I_HYB2)[l * 64 + lane];
#pragma unroll 16
    for (int i = 0; i < 64; ++i) pre2 += __shfl(h1, i) * w2[i * 64 + lane];
    out[lane] = f2bf(sin_rad(fq * pre2));
}
__device__ __forceinline__ void p0_prologue(const Args& a, LAS unsigned char* lds, int G, int bid, int tid, int wave, int lane) {
    for (int u = bid; u < NLAYER * 96; u += G) ada_unit(a, u, lds, tid, wave, lane);
    const int gw = bid * NWAVES + wave, NGW = G * NWAVES;
    for (int it = gw; it < NLAYER * (SEQ + CTXL); it += NGW) hid_item(a, it, lane);
    if (bid == G - 1) {
        float* rope = (float*)(wsb() + WS_ROPE);
        for (int i = tid; i < 64 * 32; i += NTHR) { const int pos = i >> 5, f = i & 31; const float inv = __builtin_amdgcn_exp2f(-(float)f * (13.287712379549449f / 32.0f));
            const float ang = (float)pos * inv; float rev = ang * 0.15915494309189535f; rev -= floorf(rev);
            rope[2 * i] = __builtin_amdgcn_cosf(rev); rope[2 * i + 1] = __builtin_amdgcn_sinf(rev); }
        if (wave < NLAYER) { const float* lv = inp(I_ATTLAM) + (size_t)wave * 4 * 128;
            float s1 = lv[lane] * lv[128 + lane] + lv[64 + lane] * lv[192 + lane], s2 = lv[256 + lane] * lv[384 + lane] + lv[320 + lane] * lv[448 + lane];
            s1 = wave_sum(s1); s2 = wave_sum(s2);
            const float lam_init = 0.8f - 0.6f * fast_exp(-0.3f * (float)wave);
            if (lane == 0) ((float*)(wsb() + WS_LAMS))[wave] = fast_exp(s1) - fast_exp(s2) + lam_init; }
    }
    for (int i = (bid * NWAVES + wave) * 64 + lane; i < 8192; i += G * NTHR) { int r, k, den;
        if (i < 64) { r = 1 + i / 8; k = i % 8; den = 64; if (r > 7) { r = 0; } }
        else if (i < 512) { r = 1 + (i - 64) / 64; k = (i - 64) % 64; den = 512; }
        else { r = 1 + (i - 512) / 512; k = (i - 512) % 512; den = 8192; }
        float rev = -(float)(r * k) / (float)den; rev -= rintf(rev);
        ((f32x2*)(wsb() + WS_TW))[i] = (f32x2){__builtin_amdgcn_cosf(rev), __builtin_amdgcn_sinf(rev)}; }
    for (int i = (bid * NWAVES + wave) * 64 + lane; i < NLAYER * NEXP * DM; i += G * NTHR) { const int l = i / (NEXP * DM), e = (i / DM) % NEXP, k = i % DM;
        const float w = inp(I_RW)[((size_t)l * DM + k) * NEXP + e]; const bf16 hi = f2bf(w); const bf16 lo = f2bf(w - bf2f(hi));
        bf16* T = (bf16*)(wsb() + WS_RWT) + (size_t)l * 2 * NEXP * DM; T[(size_t)e * DM + k] = hi; T[(size_t)(NEXP + e) * DM + k] = lo; }
    LAS float* scr = (LAS float*)(lds + wave * (64 * 65 * 4));
    {   constexpr int NIT = NLAYER * TI_LAYER; const int n_ada = NLAYER * 96, n_free = G - n_ada;
        int n1 = NIT;
        if (n_free > 0) { const int xa = (NIT + 64 * n_ada) / G - 64; n1 = xa > 0 ? xa * G : 0; if (n1 > NIT) n1 = NIT; }
        for (int it = gw; it < n1; it += NGW) tr_item(a, it, scr, lane);
        if (n_free > 0 && bid >= n_ada) for (int it = n1 + (bid - n_ada) * NWAVES + wave; it < NIT; it += n_free * NWAVES) tr_item(a, it, scr, lane); }
}

__device__ __forceinline__ void p_filt(int l, int G, int bid, int wave, int lane) {
    asm volatile("" : "+v"(lane));
    const bf16* W3T = (const bf16*)(wsb() + WS_W3T) + (size_t)l * 2048 * 64; const bf16* HB = (const bf16*)(wsb() + WS_HIDB) + (size_t)l * RB * 64;
    float* F = (float*)(wsb() + WS_FILT) + (size_t)l * 2048 * RB;
    const int fr = lane & 15, fq = lane >> 4;
    for (int it = bid * NWAVES + wave; it < 64 * 68; it += G * NWAVES) { const int fc0 = (it / 68) * 32, lg0 = (it % 68) * 64;
        bf16x8 af[2][2], bfm[4][2];
#pragma unroll
        for (int mt = 0; mt < 2; ++mt)
#pragma unroll
            for (int ks = 0; ks < 2; ++ks) af[mt][ks] = *(const bf16x8*)(W3T + (size_t)(fc0 + 16 * mt + fr) * 64 + 8 * fq + 32 * ks);
#pragma unroll
        for (int nt = 0; nt < 4; ++nt)
#pragma unroll
            for (int ks = 0; ks < 2; ++ks) bfm[nt][ks] = *(const bf16x8*)(HB + (size_t)(lg0 + 16 * nt + fr) * 64 + 8 * fq + 32 * ks);
#pragma unroll
        for (int mt = 0; mt < 2; ++mt)
#pragma unroll
            for (int nt = 0; nt < 4; ++nt) { f32x4 c = {0.f, 0.f, 0.f, 0.f};
#pragma unroll
                for (int ks = 0; ks < 2; ++ks) c = __builtin_amdgcn_mfma_f32_16x16x32_bf16(bfm[nt][ks], af[mt][ks], c, 0, 0, 0);
                *(f32x4*)(F + (size_t)(fc0 + 16 * mt + fr) * RB + lg0 + 16 * nt + 4 * fq) = c; }
    }
}
__device__ __forceinline__ void p_ln1(const Args& a, int l, int G, int bid, int wave, int lane) {
    asm volatile("" : "+v"(lane));
    const float* mod = (const float*)(wsb() + WS_MOD) + (size_t)l * 3 * (6 * DM);
    bf16* A1 = (bf16*)(wsb() + WS_A1);
    for (int r = bid * NWAVES + wave; r < M; r += G * NWAVES) {
        const float* xr = (l == 0) ? xin_row(inp(I_X), inp(I_CTX), r) : (const float*)(wsb() + WS_XB) + (size_t)r * DM;
        const float* mv = mod + (size_t)row_mod(r) * (6 * DM);
        f32x4 v[8]; float s = 0.f;
#pragma unroll
        for (int j = 0; j < 8; ++j) { v[j] = ((const f32x4*)xr)[lane + 64 * j]; s += (v[j][0] + v[j][1]) + (v[j][2] + v[j][3]); }
        const float mean = wave_sum(s) * (1.f / DM); float s2 = 0.f;
#pragma unroll
        for (int j = 0; j < 8; ++j) { v[j] = v[j] - mean; s2 += (v[j][0] * v[j][0] + v[j][1] * v[j][1]) + (v[j][2] * v[j][2] + v[j][3] * v[j][3]); }
        const float rstd = 1.f / sqrtf(wave_sum(s2) * (1.f / DM) + LN_EPS);
        f32x4 shv[8], scv[8];
#pragma unroll
        for (int j = 0; j < 8; ++j) { shv[j] = ((const f32x4*)mv)[lane + 64 * j]; scv[j] = ((const f32x4*)(mv + DM))[lane + 64 * j]; }
#pragma unroll
        for (int j = 0; j < 8; ++j) { const f32x4 sh = shv[j], sc = scv[j];
            const f32x4 o = v[j] * rstd * (sc + 1.f) + sh;
#if FP8_IN
            int w8 = 0; w8 = cvt2_fp8(o[0], o[1], w8, false); w8 = cvt2_fp8(o[2], o[3], w8, true); ((unsigned*)((unsigned char*)A1 + (size_t)r * DM))[lane + 64 * j] = (unsigned)w8; }
#else
            u32x2 w; w.x = pk_bf16(o[0], o[1]); w.y = pk_bf16(o[2], o[3]);
            ((u32x2*)(A1 + (size_t)r * DM))[lane + 64 * j] = w; }
#endif
    }
}

constexpr int FN = 8192;
__device__ __forceinline__ f32x2 zero2() { float z = 0.f; asm volatile("" : "+v"(z)); return (f32x2){z, z}; }
__device__ __forceinline__ f32x2 cmul(f32x2 a, f32x2 b) { return (f32x2){a.x * b.x - a.y * b.y, a.x * b.y + a.y * b.x}; }
#define PADI(i) ((i) + ((i) >> 5))
constexpr int FNP = FN + FN / 32;
__device__ __forceinline__ void dft4(f32x2& v0, f32x2& v1, f32x2& v2, f32x2& v3) { const f32x2 a0 = v0 + v2, a1 = v0 - v2, a2 = v1 + v3, t = v1 - v3; const f32x2 a3 = {t.y, -t.x}; v0 = a0 + a2; v1 = a1 + a3; v2 = a0 - a2; v3 = a1 - a3; }
__device__ __forceinline__ void dft8(f32x2 (&a)[8]) {
    const float R = 0.70710678118654752f;
    f32x2 b0 = a[0] + a[4], b4 = a[0] - a[4];
    f32x2 b1 = a[1] + a[5]; const f32x2 t1 = a[1] - a[5]; f32x2 b5 = {(t1.x + t1.y) * R, (t1.y - t1.x) * R};
    f32x2 b2 = a[2] + a[6]; const f32x2 t2 = a[2] - a[6]; f32x2 b6 = {t2.y, -t2.x};
    f32x2 b3 = a[3] + a[7]; const f32x2 t3 = a[3] - a[7]; f32x2 b7 = {(t3.y - t3.x) * R, (-t3.x - t3.y) * R};
    dft4(b0, b1, b2, b3); dft4(b4, b5, b6, b7);
    a[0] = b0; a[2] = b1; a[4] = b2; a[6] = b3; a[1] = b4; a[3] = b5; a[5] = b6; a[7] = b7;
}
__device__ __forceinline__ void dft16(f32x2 (&a)[16]) {
    const float C1 = 0.92387953251128674f, S1 = 0.38268343236508977f, R = 0.70710678118654752f;
    f32x2 lo[8], hi[8];
#pragma unroll
    for (int r = 0; r < 8; ++r) { lo[r] = a[r] + a[r + 8]; hi[r] = a[r] - a[r + 8]; }
    hi[1] = cmul(hi[1], (f32x2){C1, -S1}); hi[2] = (f32x2){(hi[2].x + hi[2].y) * R, (hi[2].y - hi[2].x) * R}; hi[3] = cmul(hi[3], (f32x2){S1, -C1});
    hi[4] = (f32x2){hi[4].y, -hi[4].x}; hi[5] = cmul(hi[5], (f32x2){-S1, -C1}); hi[6] = (f32x2){(hi[6].y - hi[6].x) * R, (-hi[6].x - hi[6].y) * R}; hi[7] = cmul(hi[7], (f32x2){-C1, -S1});
    dft8(lo); dft8(hi);
#pragma unroll
    for (int m = 0; m < 8; ++m) { a[2 * m] = lo[m]; a[2 * m + 1] = hi[m]; }
}
template <int Ns, bool ZIN = false> __device__ __forceinline__ void fft_pass8(LAS f32x2* buf, const f32x2* tw, int tid) {
    f32x2 v[2][8];
#pragma unroll
    for (int q = 0; q < 2; ++q) { const int j = tid + NTHR * q, k = j & (Ns - 1);
        f32x2 w[7];
        if (Ns > 1) {
#pragma unroll
            for (int r = 1; r < 8; ++r) w[r - 1] = tw[(r - 1) * Ns + k]; }
#pragma unroll
        for (int r = 0; r < 8; ++r) v[q][r] = (ZIN && r >= 4) ? (f32x2){0.f, 0.f} : buf[PADI(j + r * (FN / 8))];
        if (Ns > 1) {
#pragma unroll
            for (int r = 1; r < 8; ++r) v[q][r] = cmul(v[q][r], w[r - 1]); }
        dft8(v[q]); }
    __syncthreads();
#pragma unroll
    for (int q = 0; q < 2; ++q) { const int j = tid + NTHR * q, k = j & (Ns - 1), j0 = ((j - k) << 3) + k;
#pragma unroll
        for (int m = 0; m < 8; ++m) buf[PADI(j0 + m * Ns)] = v[q][m]; }
    __syncthreads();
}
template <bool ZIN, bool LOUT> __device__ __forceinline__ void fft8192(LAS f32x2* buf, int tid) {
    asm volatile("" : "+v"(tid));
    const f32x2* tw = (const f32x2*)(wsb() + WS_TW);
    fft_pass8<1, ZIN>(buf, tw, tid); fft_pass8<8>(buf, tw, tid); fft_pass8<64>(buf, tw + 64, tid);
    {   f32x2 v[16], w[15];
#pragma unroll
        for (int r = 1; r < 16; ++r) w[r - 1] = tw[512 + (r - 1) * 512 + tid];
#pragma unroll
        for (int r = 0; r < 16; ++r) v[r] = buf[PADI(tid + r * 512)];
#pragma unroll
        for (int r = 1; r < 16; ++r) v[r] = cmul(v[r], w[r - 1]);
        dft16(v);
        __syncthreads();
#pragma unroll
        for (int m = 0; m < (LOUT ? 8 : 16); ++m) buf[PADI(tid + m * 512)] = v[m];
        __syncthreads(); }
}
__device__ __forceinline__ float block_sum(float v, LAS float* red, int tid, int wave, int lane) {
    v = wave_sum(v); __syncthreads(); if (lane == 0) red[wave] = v; __syncthreads();
    float s = 0.f;
#pragma unroll
    for (int w = 0; w < NWAVES; ++w) s += red[w];
    return s;
}
__device__ __forceinline__ float hy_decay(int c) { const float mn = -3.0701134573253945f, mx = -15.350567286626973f; return -(mn + (mx - mn) * ((float)c / 511.0f)); }
__device__ __forceinline__ float hy_conv3(const bf16* rowp, int t, int n, float w0, float w1, float w2, float bias) {
    const float um = bf2f(rowp[t > 0 ? t - 1 : 0]), u0 = bf2f(rowp[t]), up = bf2f(rowp[t + 1 < n ? t + 1 : t]);
    return w0 * (t > 0 ? um : 0.f) + w1 * u0 + w2 * (t + 1 < n ? up : 0.f) + bias;
}
__device__ __forceinline__ void hyena_lat_unit(const Args& a, int l, int c, LAS unsigned char* lds, int tid, int wave, int lane) {
    asm volatile("" : "+v"(tid), "+v"(lane));
    LAS f32x2* ZB = (LAS f32x2*)lds; LAS f32x2* GH = ZB + FNP; LAS float* red = (LAS float*)(GH + FNP);
    const float* F = (const float*)(wsb() + WS_FILT) + (size_t)l * 2048 * RB + (size_t)c * RB;
    const float dec = hy_decay(c);
    float s0 = 0.f, s1 = 0.f;
    float fv[8][4];
#pragma unroll
    for (int q = 0; q < 8; ++q) { const int t = tid + NTHR * q; fv[q][0] = F[t]; fv[q][1] = F[(size_t)512 * RB + t]; fv[q][2] = F[(size_t)1024 * RB + t]; fv[q][3] = F[(size_t)1536 * RB + t]; }
#pragma unroll
    for (int q = 0; q < 8; ++q) { const int t = tid + NTHR * q;
        const float dm = fast_exp(-((float)t / 4095.0f) * dec);
        const float a0 = fv[q][0] * dm, a1 = fv[q][1] * dm, a2 = fv[q][2] * dm, a3 = fv[q][3] * dm;
        GH[PADI(t)] = (f32x2){a0, a1}; s0 += fabsf(a0); s1 += fabsf(a1);
        if (t >= 1) { GH[PADI(FN - t)] = (f32x2){a2, a3}; s0 += fabsf(a2); s1 += fabsf(a3); }
        if (t == 0) GH[PADI(FN / 2)] = zero2(); }
    const float S0 = block_sum(s0, red, tid, wave, lane); const float S1 = block_sum(s1, red, tid, wave, lane);
    __syncthreads();
    fft8192<false, false>(GH, tid);
    const float i0 = 0.5f / S0, i1 = 0.5f / S1;
    const bf16* HYT = (const bf16*)(wsb() + WS_HYT);
    const float* cw = inp(I_HYCW) + (size_t)l * 3 * NHY; const float* cbias = inp(I_HYCB) + (size_t)l * NHY;
    float z[8][2];
    {   const int ch = 1024 + c; const float w0 = cw[ch], w1 = cw[NHY + ch], w2 = cw[2 * NHY + ch], bb = cbias[ch];
#pragma unroll
        for (int q = 0; q < 8; ++q) { const int t = tid + NTHR * q;
#pragma unroll
            for (int b = 0; b < 2; ++b) z[q][b] = hy_conv3(HYT + (size_t)ch * M + b * RB + CTXL, t, SEQ, w0, w1, w2, bb);
            ZB[PADI(t)] = (f32x2){z[q][0], z[q][1]}; } }
    __syncthreads();
    for (int o = 0; o < 2; ++o) {
        fft8192<true, false>(ZB, tid);
#pragma unroll 4
        for (int q = 0; q < 16; ++q) { const int k = tid + NTHR * q; const f32x2 g = GH[PADI(k)], gm = GH[PADI((FN - k) & (FN - 1))]; f32x2 H;
            if (o == 0) H = (f32x2){(g.x + gm.x) * i0, (g.y - gm.y) * i0};
            else        H = (f32x2){(g.y + gm.y) * i1, (gm.x - g.x) * i1};
            const f32x2 p = cmul(ZB[PADI(k)], H); ZB[PADI(k)] = (f32x2){p.x, -p.y}; }
        __syncthreads();
        fft8192<false, true>(ZB, tid);
        const int ch = o * 512 + c; const float w0 = cw[ch], w1 = cw[NHY + ch], w2 = cw[2 * NHY + ch], bb = cbias[ch];
        const float sk = inp(I_HYSKIP)[((size_t)l * 2 + o) * HYW + c];
#pragma unroll
        for (int q = 0; q < 8; ++q) { const int t = tid + NTHR * q; const f32x2 y = ZB[PADI(t)];
            const float zc0 = y.x * (1.0f / FN), zc1 = -y.y * (1.0f / FN);
            const float g0 = hy_conv3(HYT + (size_t)ch * M + CTXL, t, SEQ, w0, w1, w2, bb), g1 = hy_conv3(HYT + (size_t)ch * M + RB + CTXL, t, SEQ, w0, w1, w2, bb);
            z[q][0] = g0 * (zc0 + sk * z[q][0]); z[q][1] = g1 * (zc1 + sk * z[q][1]); }
        __syncthreads();
        if (o == 0) {
#pragma unroll
            for (int q = 0; q < 8; ++q) { const int t = tid + NTHR * q; ZB[PADI(t)] = (f32x2){z[q][0], z[q][1]}; }
            __syncthreads();
        }
    }
    bf16* YHT = (bf16*)(wsb() + WS_YHT) + (size_t)c * M;
#pragma unroll
    for (int q = 0; q < 8; ++q) { const int t = tid + NTHR * q; YHT[CTXL + t] = f2bf(z[q][0]); YHT[RB + CTXL + t] = f2bf(z[q][1]); }
    __syncthreads();
}
__device__ __forceinline__ void hyena_ctx_unit(const Args& a, int l, int c, LAS unsigned char* lds, int tid, int wave, int lane) {
    asm volatile("" : "+v"(tid), "+v"(lane));
    LAS float* hf = (LAS float*)lds; LAS float* zz = hf + 1024; LAS float* red = zz + 512;
    const float* F = (const float*)(wsb() + WS_FILT) + (size_t)l * 2048 * RB + (size_t)c * RB + SEQ;
    const float dec = hy_decay(c);
    float s0 = 0.f, s1 = 0.f;
    if (tid < CTXL) { const int t = tid;
        const float dm = fast_exp(-((float)t / 255.0f) * dec);
        const float a0 = F[t] * dm, a1 = F[(size_t)512 * RB + t] * dm, a2 = F[(size_t)1024 * RB + t] * dm, a3 = F[(size_t)1536 * RB + t] * dm;
        hf[256 + t] = a0; hf[512 + 256 + t] = a1; s0 += fabsf(a0); s1 += fabsf(a1);
        if (t >= 1) { hf[256 - t] = a2; hf[512 + 256 - t] = a3; s0 += fabsf(a2); s1 += fabsf(a3); }
        if (t == 0) { hf[0] = 0.f; hf[512] = 0.f; } }
    const float S0 = block_sum(s0, red, tid, wave, lane); const float S1 = block_sum(s1, red, tid, wave, lane);
    const bf16* HYT = (const bf16*)(wsb() + WS_HYT);
    const float* cw = inp(I_HYCW) + (size_t)l * 3 * NHY; const float* cbias = inp(I_HYCB) + (size_t)l * NHY;
    const int b = tid >> 8, t = tid & 255;
    float z;
    {   const int ch = 1024 + c; z = hy_conv3(HYT + (size_t)ch * M + b * RB, t, CTXL, cw[ch], cw[NHY + ch], cw[2 * NHY + ch], cbias[ch]); }
    __syncthreads();
    for (int o = 0; o < 2; ++o) {
        zz[b * 256 + t] = z; __syncthreads();
        const LAS float* h = hf + o * 512 + 256; const LAS float* zb = zz + b * 256; float acc = 0.f;
#pragma unroll 8
        for (int s = 0; s < CTXL; ++s) acc += h[t - s] * zb[s];
        acc *= 1.0f / (o == 0 ? S0 : S1);
        const int ch = o * 512 + c; const float g = hy_conv3(HYT + (size_t)ch * M + b * RB, t, CTXL, cw[ch], cw[NHY + ch], cw[2 * NHY + ch], cbias[ch]);
        z = g * (acc + inp(I_HYSKIP)[((size_t)l * 2 + o) * HYW + c] * z);
        __syncthreads();
    }
    ((bf16*)(wsb() + WS_YHT))[(size_t)c * M + b * RB + t] = f2bf(z);
    __syncthreads();
}

__device__ __forceinline__ int lru_ord(int d, int ch) { return d == 0 ? ch : (ch < 2 ? 1 - ch : 2 + (33 - ch)); }
template <int PASS>
__device__ __forceinline__ void lru_unit(const Args& a, int l, int u, LAS unsigned char* lds, int tid, int wave, int lane) {
    asm volatile("" : "+v"(tid), "+v"(lane));
    const int b = u / (8 * LRU_NCH), hd = (u / LRU_NCH) % 8, ch = u % LRU_NCH;
    LAS float* AB = (LAS float*)lds; LAS float* BB = AB + 128 * 64; LAS bf16* XR = (LAS bf16*)(BB + 128 * 64);
    LAS bf16* WT = XR + 128 * 72; LAS float* SEG = (LAS float*)(WT + 4 * 64 * 72); LAS float* CIN = SEG + 8 * 64 * 2;
    const bf16* U = (const bf16*)(wsb() + WS_U);
    const int p0 = ch * LRU_CH; const int reg_lo = ch < 2 ? 0 : CTXL, reg_hi = ch < 2 ? CTXL : RB;
    const size_t rowbase = (size_t)b * RB;
    const int sch = tid & 63, seg = tid >> 6;
    const int cg = tid & 7; const float* cw = inp(I_LCW) + (size_t)l * 4 * 512 + hd * 64 + 8 * cg; const float* cbv = inp(I_LCB) + (size_t)l * 512 + hd * 64 + 8 * cg;
    f32x4 wv[4][2], bias[2]; u32x4 raw[2][4]; f32x4 va[2][2], vx[2][2];
#pragma unroll
    for (int jt = 0; jt < 2; ++jt)
#pragma unroll
        for (int j = 0; j < 4; ++j) { const int p = p0 + (tid >> 3) + 64 * jt, pp = p + j - 2; const bool ok = (pp >= reg_lo && pp < reg_hi);
            raw[jt][j] = *(const u32x4*)(U + (rowbase + (ok ? pp : p)) * NREST + UC_REC + hd * 64 + 8 * cg); }
#pragma unroll
    for (int j = 0; j < 4; ++j) { wv[j][0] = *(const f32x4*)(cw + j * 512); wv[j][1] = *(const f32x4*)(cw + j * 512 + 4); }
    bias[0] = *(const f32x4*)cbv; bias[1] = *(const f32x4*)(cbv + 4);
#pragma unroll
    for (int d = 0; d < 2; ++d) { const float* wa = inp(I_LWA) + ((((size_t)l * 2 + d) * 8 + hd) * 64) * 64; const float* wx = inp(I_LWX) + ((((size_t)l * 2 + d) * 8 + hd) * 64) * 64;
#pragma unroll
        for (int j = 0; j < 2; ++j) { va[d][j] = ((const f32x4*)wa)[tid + NTHR * j]; vx[d][j] = ((const f32x4*)wx)[tid + NTHR * j]; } }
    bf16 gt[16];
    if (PASS == 2) {
#pragma unroll
        for (int i = 0; i < 16; ++i) gt[i] = U[(rowbase + p0 + 16 * seg + i) * NREST + UC_GATE + hd * 64 + sch];
        if (tid < 128) { const int d = tid >> 6, c64 = tid & 63; const int ord = lru_ord(d, ch); const f32x2* agg = (const f32x2*)(wsb() + WS_LRUAGG) + (((size_t)b * 2 + d) * LRU_NCH * 512 + hd * 64 + c64);
            f32x2 ab[LRU_NCH];
#pragma unroll
            for (int q = 0; q < LRU_NCH; ++q) ab[q] = agg[(size_t)q * 512];
            float h = 0.f;
#pragma unroll
            for (int q = 0; q < LRU_NCH; ++q) { const float hn = ab[q].x * h + ab[q].y; h = (q < ord) ? hn : h; }
            CIN[d * 64 + c64] = h; }
    }
#pragma unroll
    for (int jt = 0; jt < 2; ++jt) { const int t = (tid >> 3) + 64 * jt, p = p0 + t;
        f32x4 a0 = bias[0], a1 = bias[1];
#pragma unroll
        for (int j = 0; j < 4; ++j) { const int pp = p + j - 2; const bool ok = (pp >= reg_lo && pp < reg_hi); const u32x4 rw = ok ? raw[jt][j] : (u32x4){0u, 0u, 0u, 0u};
            const f32x4 lo = {__uint_as_float(rw.x << 16), __uint_as_float(rw.x & 0xffff0000u), __uint_as_float(rw.y << 16), __uint_as_float(rw.y & 0xffff0000u)};
            const f32x4 hi4 = {__uint_as_float(rw.z << 16), __uint_as_float(rw.z & 0xffff0000u), __uint_as_float(rw.w << 16), __uint_as_float(rw.w & 0xffff0000u)};
            a0 += wv[j][0] * lo; a1 += wv[j][1] * hi4; }
        u32x4 pk; pk.x = pk_bf16(a0[0], a0[1]); pk.y = pk_bf16(a0[2], a0[3]); pk.z = pk_bf16(a1[0], a1[1]); pk.w = pk_bf16(a1[2], a1[3]);
        *(LAS u32x4*)(XR + t * 72 + 8 * cg) = pk; }
#pragma unroll
    for (int d = 0; d < 2; ++d)
#pragma unroll
        for (int j = 0; j < 2; ++j) { const int idx = tid + NTHR * j, k = idx >> 4, n4 = (idx & 15) * 4;
#pragma unroll
            for (int q = 0; q < 4; ++q) { WT[(d * 2 + 0) * 64 * 72 + (n4 + q) * 72 + k] = f2bf(va[d][j][q]); WT[(d * 2 + 1) * 64 * 72 + (n4 + q) * 72 + k] = f2bf(vx[d][j][q]); } }
    float hsum[16];
#pragma unroll
    for (int i = 0; i < 16; ++i) hsum[i] = 0.f;
    for (int d = 0; d < 2; ++d) {
        __syncthreads();
        {   const int fr = lane & 15, fq = lane >> 4;
            bf16x8 af[2];
#pragma unroll
            for (int ks = 0; ks < 2; ++ks) af[ks] = *(const LAS bf16x8*)(XR + (16 * wave + fr) * 72 + 8 * fq + 32 * ks);
            const float* bav = inp(I_LBA) + ((size_t)l * 2 + d) * 512 + hd * 64; const float* bxv = inp(I_LBX) + ((size_t)l * 2 + d) * 512 + hd * 64;
            const float* lamv = inp(I_LLAM) + ((size_t)l * 2 + d) * 512 + hd * 64;
            float bav4[4], bxv4[4], lam4[4];
#pragma unroll
            for (int nt = 0; nt < 4; ++nt) { bav4[nt] = bav[16 * nt + fr]; bxv4[nt] = bxv[16 * nt + fr]; lam4[nt] = lamv[16 * nt + fr]; }
            const LAS bf16* Wd = WT + d * 2 * 64 * 72;
#pragma unroll
            for (int nt = 0; nt < 4; ++nt) {
                f32x4 ar = {0.f, 0.f, 0.f, 0.f}, ai = ar;
#pragma unroll
                for (int ks = 0; ks < 2; ++ks) { const bf16x8 bfa = *(const LAS bf16x8*)(Wd + (16 * nt + fr) * 72 + 8 * fq + 32 * ks); const bf16x8 bfx = *(const LAS bf16x8*)(Wd + 64 * 72 + (16 * nt + fr) * 72 + 8 * fq + 32 * ks);
                    ar = __builtin_amdgcn_mfma_f32_16x16x32_bf16(af[ks], bfa, ar, 0, 0, 0); ai = __builtin_amdgcn_mfma_f32_16x16x32_bf16(af[ks], bfx, ai, 0, 0, 0); }
                const int cc = 16 * nt + fr; const float ba = bav4[nt], bx = bxv4[nt], lam = lam4[nt];
                const float ex = fast_exp(-lam); const float sp = (ex < 0.06f) ? ex * (1.f - ex * (0.5f - ex * (0.33333334f - 0.25f * ex))) : __logf(1.f + ex);
#pragma unroll
                for (int g = 0; g < 4; ++g) { const int t = 16 * wave + 4 * fq + g;
                    const float r = sigm(ar[g] + ba), ig = sigm(ai[g] + bx);
                    const float la = -8.0f * r * sp, x2 = 2.f * la;
                    const float em = (x2 > -0.25f) ? -x2 * (1.f + x2 * (0.5f + x2 * (0.16666667f + x2 * (0.041666668f + x2 * 0.0083333333f)))) : 1.f - fast_exp(x2);
                    AB[t * 64 + cc] = fast_exp(la); BB[t * 64 + cc] = sqrtf(fmaxf(em, 0.f)) * (ig * bf2f(XR[t * 72 + cc])); } }
        }
        __syncthreads();
        float A = 1.f, Bv = 0.f;
#pragma unroll
        for (int i = 0; i < 16; ++i) { const int t = d == 0 ? 16 * seg + i : 16 * seg + 15 - i; const float av = AB[t * 64 + sch], bv = BB[t * 64 + sch]; Bv = av * Bv + bv; A *= av; }
        SEG[(seg * 64 + sch) * 2] = A; SEG[(seg * 64 + sch) * 2 + 1] = Bv;
        __syncthreads();
        if (PASS == 1) {
            if (tid < 64) { float CA = 1.f, CB = 0.f;
#pragma unroll
                for (int s = 0; s < 8; ++s) { const int sg = d == 0 ? s : 7 - s; const float sa = SEG[(sg * 64 + tid) * 2], sb = SEG[(sg * 64 + tid) * 2 + 1]; CB = sa * CB + sb; CA *= sa; }
                f32x2* agg = (f32x2*)(wsb() + WS_LRUAGG) + ((((size_t)b * 2 + d) * LRU_NCH + lru_ord(d, ch)) * 512 + hd * 64 + tid);
                *agg = (f32x2){CA, CB}; }
        } else {
            float h = CIN[d * 64 + sch];
            for (int s = 0; s < 8; ++s) { const int sg = d == 0 ? s : 7 - s; const bool before = d == 0 ? (sg < seg) : (sg > seg);
                if (before) h = SEG[(sg * 64 + sch) * 2] * h + SEG[(sg * 64 + sch) * 2 + 1]; }
#pragma unroll
            for (int i = 0; i < 16; ++i) { if (d == 0) { const int t = 16 * seg + i; h = AB[t * 64 + sch] * h + BB[t * 64 + sch]; hsum[i] += h; }
                                           else { const int t = 16 * seg + 15 - i; h = AB[t * 64 + sch] * h + BB[t * 64 + sch]; hsum[15 - i] += h; } }
        }
    }
    if (PASS == 2) {
        bf16* MIX = (bf16*)(wsb() + WS_MIX);
#pragma unroll
        for (int i = 0; i < 16; ++i) { const size_t row = rowbase + p0 + 16 * seg + i; const float y = hsum[i] * gelu_tanh(bf2f(gt[i]));
#if FP8_OUT
            ((unsigned char*)MIX)[row * DM + 512 + hd * 64 + sch] = (unsigned char)(cvt2_fp8(y * MIX8_SCALE, 0.f, 0, false) & 0xff); }
#else
            MIX[row * DM + 512 + hd * 64 + sch] = f2bf(y); }
#endif
    }
    __syncthreads();
}

__device__ __forceinline__ void p_mix3(const Args& a, int l, LAS unsigned char* lds, int G, int bid, int tid, int wave, int lane, int sub = 7) {
    asm volatile("" : "+v"(tid), "+v"(lane));
    bf16* MIX = (bf16*)(wsb() + WS_MIX);
    if (sub & 1) {
        const float* O0 = (const float*)(wsb() + WS_OATT); const float* O1 = O0 + (size_t)M * 1024;
        const float lam = ((const float*)(wsb() + WS_LAMS))[l]; const float lam_init = 0.8f - 0.6f * fast_exp(-0.3f * (float)l);
        const f32x4 gn = ((const f32x4*)(inp(I_SUBLN) + (size_t)l * 256))[lane];
        for (int row = bid * NWAVES + wave; row < M; row += G * NWAVES) {
            if (l == NLAYER - 1 && (row < CTXL || (row >= RB && row < RB + CTXL))) continue;
            f32x4 x0[4], x1[4];
#pragma unroll
            for (int h = 0; h < 4; ++h) { x0[h] = ((const f32x4*)(O0 + (size_t)row * 1024 + h * 256))[lane]; x1[h] = ((const f32x4*)(O1 + (size_t)row * 1024 + h * 256))[lane]; }
#pragma unroll
            for (int h = 0; h < 4; ++h) { const f32x4 o = x0[h] - x1[h] * lam; const float ss = wave_sum((o[0] * o[0] + o[1] * o[1]) + (o[2] * o[2] + o[3] * o[3]));
                const float sc = (1.f / sqrtf(ss * (1.f / 256.f) + LN_EPS)) * (1.f - lam_init);
                const f32x4 y = o * gn * sc;
#if FP8_OUT
                int w8 = 0; w8 = cvt2_fp8(y[0] * MIX8_SCALE, y[1] * MIX8_SCALE, w8, false); w8 = cvt2_fp8(y[2] * MIX8_SCALE, y[3] * MIX8_SCALE, w8, true);
                ((unsigned*)((unsigned char*)MIX + (size_t)row * DM + 1024 + h * 256))[lane] = (unsigned)w8; } }
#else
                u32x2 w; w.x = pk_bf16(y[0], y[1]); w.y = pk_bf16(y[2], y[3]);
                ((u32x2*)(MIX + (size_t)row * DM + 1024 + h * 256))[lane] = w; } }
#endif
    }
    if (sub & 2) {
        const bf16* YHT = (const bf16*)(wsb() + WS_YHT); LAS bf16* T = (LAS bf16*)lds;
        for (int u = G - 1 - bid; u < M / 64; u += G) { const int r0 = u * 64;
            __syncthreads();
            for (int i = tid; i < 512 * 8; i += NTHR) { const int c = i >> 3, k = i & 7; const u32x4 v = *(const u32x4*)(YHT + (size_t)c * M + r0 + 8 * k);
                LAS unsigned* d = (LAS unsigned*)(T + c * 66 + 8 * k); d[0] = v.x; d[1] = v.y; d[2] = v.z; d[3] = v.w; }
            __syncthreads();
            for (int i = tid; i < 64 * 64; i += NTHR) { const int t = i >> 6, c8 = (i & 63) * 8; unsigned w[4];
#pragma unroll
                for (int j = 0; j < 4; ++j) w[j] = (unsigned)T[(c8 + 2 * j) * 66 + t] | ((unsigned)T[(c8 + 2 * j + 1) * 66 + t] << 16);
#if FP8_OUT
                int wa = 0, wb = 0;
                wa = cvt2_fp8(__uint_as_float(w[0] << 16) * MIX8_SCALE, __uint_as_float(w[0] & 0xffff0000u) * MIX8_SCALE, wa, false); wa = cvt2_fp8(__uint_as_float(w[1] << 16) * MIX8_SCALE, __uint_as_float(w[1] & 0xffff0000u) * MIX8_SCALE, wa, true);
                wb = cvt2_fp8(__uint_as_float(w[2] << 16) * MIX8_SCALE, __uint_as_float(w[2] & 0xffff0000u) * MIX8_SCALE, wb, false); wb = cvt2_fp8(__uint_as_float(w[3] << 16) * MIX8_SCALE, __uint_as_float(w[3] & 0xffff0000u) * MIX8_SCALE, wb, true);
                *(u32x2*)((unsigned char*)MIX + (size_t)(r0 + t) * DM + c8) = (u32x2){(unsigned)wa, (unsigned)wb}; }
#else
                *(u32x4*)(MIX + (size_t)(r0 + t) * DM + c8) = (u32x4){w[0], w[1], w[2], w[3]}; }
#endif
        }
        __syncthreads();
    }
}

__device__ __forceinline__ void wave_sum2(float& a0, float& a1) {
#pragma unroll
    for (int o = 1; o < 64; o <<= 1) { const float t0 = __shfl_xor(a0, o), t1 = __shfl_xor(a1, o); a0 += t0; a1 += t1; }
}
__device__ __forceinline__ void p_ln2(const Args& a, int l, LAS unsigned char* lds, int G, int bid, int tid, int wave, int lane, int sub = 7) {
    asm volatile("" : "+v"(tid), "+v"(lane));
    const float* mod = (const float*)(wsb() + WS_MOD) + (size_t)l * 3 * (6 * DM);
    const bf16* Rb = (const bf16*)(wsb() + WS_RBUF); bf16* XA = (bf16*)(wsb() + WS_XA); unsigned char* H2 = wsb() + WS_H2;
    bf16* Hhi = (bf16*)(wsb() + WS_H2F); bf16* Hlo = Hhi + (size_t)M * DM;
    const float* lg = inp(I_LNG) + ((size_t)l * 2 + 0) * DM; const float* lb = inp(I_LNB) + ((size_t)l * 2 + 0) * DM;
    const bf16* RWT = (const bf16*)(wsb() + WS_RWT) + (size_t)l * 2 * NEXP * DM; const float* rbias = inp(I_RB) + (size_t)l * NEXP;
    unsigned* cnt = (unsigned*)(wsb() + WS_CTL) + CW_CNT + 64 * l * CNT_ST;
    int* ltok = (int*)(wsb() + WS_LIST); int* ldst = ltok + (size_t)NEXP * LCAP; int* lw = ldst + (size_t)NEXP * LCAP;
    LAS float* red = (LAS float*)lds;
    LAS int* sel_e = (LAS int*)(lds + 69632);
    LAS float* sel_w = (LAS float*)(lds + 69632 + 1280);
    LAS int* sel_p = (LAS int*)(lds + 69632 + 2560);
    LAS int* hist = (LAS int*)(lds + 69632 + 3840);
    LAS int* gbase = (LAS int*)(lds + 69632 + 4096);
    const int last = (l == NLAYER - 1);
    const int NR = last ? 32 : 34;
#define LN2_GROW(uu_, r0_, i_) ((i_) < 32 ? (r0_) + (i_) : ((2 * (uu_) + (i_) - 32) < CTXL ? (2 * (uu_) + (i_) - 32) : RB + (2 * (uu_) + (i_) - 32) - CTXL))
    LAS f32x4* P_lg = (LAS f32x4*)(lds + 75776); LAS f32x4* P_lb = P_lg + 512; LAS f32x4* P_sh = P_lb + 512; LAS f32x4* P_sc = P_sh + 3 * 512;
    {   const int i = tid; f32x4 t8[8];
        t8[0] = ((const f32x4*)lg)[i]; t8[1] = ((const f32x4*)lb)[i];
#pragma unroll
        for (int mi = 0; mi < 3; ++mi) { t8[2 + mi] = ((const f32x4*)(mod + (size_t)mi * (6 * DM) + 3 * DM))[i]; t8[5 + mi] = ((const f32x4*)(mod + (size_t)mi * (6 * DM) + 4 * DM))[i]; }
        P_lg[i] = t8[0]; P_lb[i] = t8[1];
#pragma unroll
        for (int mi = 0; mi < 3; ++mi) { P_sh[mi * 512 + i] = t8[2 + mi]; P_sc[mi * 512 + i] = t8[5 + mi]; } }
    __syncthreads();
    for (int uu = bid; uu < NB * SEQ / 32; uu += G) { const int u = uu + 8 + (uu >= 128 ? 8 : 0); const int r0 = u * 32;
#ifndef PROBE_DUPA
#define PROBE_DUPA 1
#endif
        if (sub & 1) for (int rp = 0; rp < ((wave == 0 && !last) ? 3 : 2); ++rp) { const int ra = (rp < 2) ? r0 + wave * 4 + 2 * rp : LN2_GROW(uu, r0, 32); const int mi = row_mod(ra);
            f32x4 v[2][8]; float s[2] = {0.f, 0.f}, q[2];
#pragma unroll
            for (int t = 0; t < 2; ++t)
#pragma unroll
                for (int jj = 0; jj < 4; ++jj) { const u32x4 w = ((const u32x4*)(Rb + (size_t)(ra + t) * DM))[lane + 64 * jj];
                    v[t][2 * jj] = (f32x4){__uint_as_float(w.x << 16), __uint_as_float(w.x & 0xffff0000u), __uint_as_float(w.y << 16), __uint_as_float(w.y & 0xffff0000u)};
                    v[t][2 * jj + 1] = (f32x4){__uint_as_float(w.z << 16), __uint_as_float(w.z & 0xffff0000u), __uint_as_float(w.w << 16), __uint_as_float(w.w & 0xffff0000u)}; }
#pragma unroll
            for (int t = 0; t < 2; ++t)
#pragma unroll
                for (int j = 0; j < 8; ++j) s[t] += (v[t][j][0] + v[t][j][1]) + (v[t][j][2] + v[t][j][3]);
            wave_sum2(s[0], s[1]);
#pragma unroll
            for (int t = 0; t < 2; ++t) { const float mean = s[t] * (1.f / DM); q[t] = 0.f;
#pragma unroll
                for (int j = 0; j < 8; ++j) { v[t][j] = v[t][j] - mean; q[t] += (v[t][j][0] * v[t][j][0] + v[t][j][1] * v[t][j][1]) + (v[t][j][2] * v[t][j][2] + v[t][j][3] * v[t][j][3]); } }
            wave_sum2(q[0], q[1]);
#pragma unroll
            for (int t = 0; t < 2; ++t) { const float rstd = 1.f / sqrtf(q[t] * (1.f / DM) + LN_EPS); s[t] = 0.f;
#pragma unroll
                for (int jj = 0; jj < 4; ++jj) {
#pragma unroll
                    for (int h = 0; h < 2; ++h) { const int j = 2 * jj + h, ci = 2 * (lane + 64 * jj) + h; v[t][j] = v[t][j] * rstd * P_lg[ci] + P_lb[ci]; s[t] += (v[t][j][0] + v[t][j][1]) + (v[t][j][2] + v[t][j][3]); }
                    ((u32x4*)(XA + (size_t)(ra + t) * DM))[lane + 64 * jj] = (u32x4){pk_bf16(v[t][2 * jj][0], v[t][2 * jj][1]), pk_bf16(v[t][2 * jj][2], v[t][2 * jj][3]), pk_bf16(v[t][2 * jj + 1][0], v[t][2 * jj + 1][1]), pk_bf16(v[t][2 * jj + 1][2], v[t][2 * jj + 1][3])}; } }
            wave_sum2(s[0], s[1]);
#pragma unroll
            for (int t = 0; t < 2; ++t) { const float mean = s[t] * (1.f / DM); q[t] = 0.f;
#pragma unroll
                for (int j = 0; j < 8; ++j) { v[t][j] = v[t][j] - mean; q[t] += (v[t][j][0] * v[t][j][0] + v[t][j][1] * v[t][j][1]) + (v[t][j][2] * v[t][j][2] + v[t][j][3] * v[t][j][3]); } }
            wave_sum2(q[0], q[1]);
#pragma unroll
            for (int t = 0; t < 2; ++t) { const float rstd = 1.f / sqrtf(q[t] * (1.f / DM) + LN_EPS); const size_t ro = (size_t)(ra + t) * DM;
#pragma unroll
                for (int jj = 0; jj < 4; ++jj) { unsigned hh[4], ll[4]; int w8[2];
#pragma unroll
                    for (int h = 0; h < 2; ++h) { const int ci = 2 * (lane + 64 * jj) + h; const f32x4 sh = P_sh[mi * 512 + ci], sc = P_sc[mi * 512 + ci];
                        const f32x4 o = v[t][2 * jj + h] * rstd * (sc + 1.f) + sh;
                        const unsigned h01 = pk_bf16(o[0], o[1]), h23 = pk_bf16(o[2], o[3]);
                        const float l0 = o[0] - __uint_as_float(h01 << 16), l1 = o[1] - __uint_as_float(h01 & 0xffff0000u), l2 = o[2] - __uint_as_float(h23 << 16), l3 = o[3] - __uint_as_float(h23 & 0xffff0000u);
                        hh[2 * h] = h01; hh[2 * h + 1] = h23; ll[2 * h] = pk_bf16(l0, l1); ll[2 * h + 1] = pk_bf16(l2, l3);
                        int w = 0; w = cvt2_fp8(o[0], o[1], w, false); w = cvt2_fp8(o[2], o[3], w, true); w8[h] = w; }
                    ((u32x4*)(Hhi + ro))[lane + 64 * jj] = (u32x4){hh[0], hh[1], hh[2], hh[3]}; ((u32x4*)(Hlo + ro))[lane + 64 * jj] = (u32x4){ll[0], ll[1], ll[2], ll[3]};
                    ((u32x2*)(H2 + ro))[lane + 64 * jj] = (u32x2){(unsigned)w8[0], (unsigned)w8[1]}; } } }
        if (tid < 64) hist[tid] = 0;
        VM_WAIT(); __syncthreads();
        if (sub & 2) {   const int fr = lane & 15, fq = lane >> 4;
            f32x4 c[3][4];
#pragma unroll
            for (int mt = 0; mt < 3; ++mt)
#pragma unroll
                for (int nt = 0; nt < 4; ++nt) c[mt][nt] = (f32x4){0.f, 0.f, 0.f, 0.f};
            const int r2 = LN2_GROW(uu, r0, 32 + (fr & 1));
            const size_t ao = (size_t)(r0 + fr) * DM + wave * 256 + 8 * fq, ao2 = (size_t)r2 * DM + wave * 256 + 8 * fq, bo = (size_t)fr * DM + wave * 256 + 8 * fq;
#pragma unroll 2
            for (int ks = 0; ks < 8; ++ks) {
                bf16x8 ah[3], al[3], bh[4], bl[4];
#pragma unroll
                for (int mt = 0; mt < 2; ++mt) { ah[mt] = *(const bf16x8*)(Hhi + ao + (size_t)(16 * mt) * DM + 32 * ks); al[mt] = *(const bf16x8*)(Hlo + ao + (size_t)(16 * mt) * DM + 32 * ks); }
                ah[2] = *(const bf16x8*)(Hhi + ao2 + 32 * ks); al[2] = *(const bf16x8*)(Hlo + ao2 + 32 * ks);
#pragma unroll
                for (int nt = 0; nt < 4; ++nt) { bh[nt] = *(const bf16x8*)(RWT + bo + (size_t)(16 * nt) * DM + 32 * ks); bl[nt] = *(const bf16x8*)(RWT + (size_t)NEXP * DM + bo + (size_t)(16 * nt) * DM + 32 * ks); }
#pragma unroll
                for (int mt = 0; mt < 3; ++mt) { if (mt == 2 && last) continue;
#pragma unroll
                    for (int nt = 0; nt < 4; ++nt) { c[mt][nt] = __builtin_amdgcn_mfma_f32_16x16x32_bf16(al[mt], bh[nt], c[mt][nt], 0, 0, 0); c[mt][nt] = __builtin_amdgcn_mfma_f32_16x16x32_bf16(ah[mt], bl[nt], c[mt][nt], 0, 0, 0);
                        c[mt][nt] = __builtin_amdgcn_mfma_f32_16x16x32_bf16(ah[mt], bh[nt], c[mt][nt], 0, 0, 0); } } }
#pragma unroll
            for (int mt = 0; mt < 3; ++mt)
#pragma unroll
                for (int nt = 0; nt < 4; ++nt)
#pragma unroll
                    for (int g = 0; g < 4; ++g) { const int row = (mt < 2) ? 16 * mt + 4 * fq + g : 32 + g;
                        if (mt < 2 || (fq == 0 && g < 2 && !last)) red[(wave * 34 + row) * 64 + 16 * nt + fr] = c[mt][nt][g]; } }
        __syncthreads();
        if (!(sub & 4)) continue;
        for (int rr = 0; rr < ((wave < 2 && !last) ? 5 : 4); ++rr) { const int row = (rr < 4) ? wave * 4 + rr : 32 + wave; float lgt = 0.f;
#pragma unroll
            for (int w = 0; w < 8; ++w) lgt += red[(w * 34 + row) * 64 + lane];
            const float score = 1.f / (1.f + __expf(-lgt)); float key = score + rbias[lane]; float ssum = 0.f; int my_slot = -1;
#pragma unroll
            for (int k = 0; k < TOPK; ++k) { const float mx = wave_max(key); const unsigned long long bal = __ballot(key == mx); const int win = bal ? __ffsll((long long)bal) - 1 : k;
                const float ws_ = __shfl(score, win); ssum += ws_; if (lane == win) { my_slot = k; key = -3.0e38f; } }
            if (my_slot >= 0) { sel_e[row * 8 + my_slot] = lane; sel_w[row * 8 + my_slot] = score / ssum * ROUTED_SCALE; sel_p[row * 8 + my_slot] = __hip_atomic_fetch_add(&hist[lane], 1, __ATOMIC_RELAXED, __HIP_MEMORY_SCOPE_WORKGROUP); } }
        __syncthreads();
        if (tid < 64) gbase[tid] = (int)__hip_atomic_fetch_add(cnt + tid * CNT_ST, (unsigned)hist[tid], RLX_AGENT);
        __syncthreads();
        if (tid < NR * 8) { const int row = tid >> 3, k = tid & 7; const int e = sel_e[tid]; const int pos = gbase[e] + sel_p[tid]; const int tok = LN2_GROW(uu, r0, row);
            ltok[(size_t)e * LCAP + pos] = tok; ldst[(size_t)e * LCAP + pos] = tok * 9 + k; lw[(size_t)e * LCAP + pos] = __float_as_int(sel_w[tid]); }
        __syncthreads();
    }
}

#ifndef FFN_GRP
#define FFN_GRP 4
#endif
__device__ __forceinline__ void p_ffnln(const Args& a, int l, LAS unsigned char* lds, int G, int bid, int wave, int lane) {
    asm volatile("" : "+v"(lane));
    const float* mod = (const float*)(wsb() + WS_MOD) + (size_t)l * 3 * (6 * DM);
    const bf16* XA = (const bf16*)(wsb() + WS_XA); const bf16* YG = (const bf16*)(wsb() + WS_YG);
    const float* lg = inp(I_LNG) + ((size_t)l * 2 + 1) * DM; const float* lb = inp(I_LNB) + ((size_t)l * 2 + 1) * DM;
    LAS f32x4* P_lg = (LAS f32x4*)lds; LAS f32x4* P_lb = P_lg + 512; LAS f32x4* P_g2 = P_lb + 512; LAS f32x4* P_sh = P_g2 + 3 * 512; LAS f32x4* P_sc = P_sh + 3 * 512;
    {   const int i = wave * 64 + lane; f32x4 t11[11]; const int nl = (l + 1 < NLAYER) ? 3 : 0;
        t11[0] = ((const f32x4*)lg)[i]; t11[1] = ((const f32x4*)lb)[i];
#pragma unroll
        for (int mi = 0; mi < 3; ++mi) { t11[2 + mi] = ((const f32x4*)(mod + (size_t)mi * (6 * DM) + 5 * DM))[i];
            t11[5 + mi] = ((const f32x4*)(mod + (size_t)(nl + mi) * (6 * DM)))[i]; t11[8 + mi] = ((const f32x4*)(mod + (size_t)(nl + mi) * (6 * DM) + DM))[i]; }
        P_lg[i] = t11[0]; P_lb[i] = t11[1];
#pragma unroll
        for (int mi = 0; mi < 3; ++mi) { P_g2[mi * 512 + i] = t11[2 + mi]; P_sh[mi * 512 + i] = t11[5 + mi]; P_sc[mi * 512 + i] = t11[8 + mi]; } }
    __syncthreads();
    for (int r = bid * NWAVES + wave; r < M; r += G * NWAVES) {
        const int b = r >= RB ? 1 : 0, p = r - b * RB;
        float* dst = nullptr; bf16* dstb = (bf16*)(wsb() + WS_XB) + (size_t)r * DM;
        if (l == NLAYER - 1) { if (p < CTXL) continue; dst = outb() + ((size_t)b * SEQ + (p - CTXL)) * DM; }
        const int mi = row_mod(r);
        f32x4 v[8]; float s = 0.f;
        const bf16* yrow = YG + (size_t)r * 9 * DM;
#pragma unroll
        for (int jp = 0; jp < 4 / FFN_GRP; ++jp) {
            u32x4 w[FFN_GRP][9], xw[FFN_GRP];
#pragma unroll
            for (int g = 0; g < FFN_GRP; ++g) { const int jj = jp * FFN_GRP + g;
#pragma unroll
                for (int k = 0; k < 9; ++k) w[g][k] = ((const u32x4*)(yrow + (size_t)k * DM))[lane + 64 * jj];
                xw[g] = ((const u32x4*)(XA + (size_t)r * DM))[lane + 64 * jj]; }
#pragma unroll
            for (int g = 0; g < FFN_GRP; ++g) { const int jj = jp * FFN_GRP + g; f32x4 f0 = {0.f, 0.f, 0.f, 0.f}, f1 = f0;
#pragma unroll
                for (int k = 0; k < 9; ++k) { const u32x4 ww = w[g][k];
                    f0[0] += __uint_as_float(ww.x << 16); f0[1] += __uint_as_float(ww.x & 0xffff0000u); f0[2] += __uint_as_float(ww.y << 16); f0[3] += __uint_as_float(ww.y & 0xffff0000u);
                    f1[0] += __uint_as_float(ww.z << 16); f1[1] += __uint_as_float(ww.z & 0xffff0000u); f1[2] += __uint_as_float(ww.w << 16); f1[3] += __uint_as_float(ww.w & 0xffff0000u); }
                const LAS f32x4* gp = P_g2 + mi * 512 + 2 * (lane + 64 * jj);
                const f32x4 x0 = {__uint_as_float(xw[g].x << 16), __uint_as_float(xw[g].x & 0xffff0000u), __uint_as_float(xw[g].y << 16), __uint_as_float(xw[g].y & 0xffff0000u)};
                const f32x4 x1 = {__uint_as_float(xw[g].z << 16), __uint_as_float(xw[g].z & 0xffff0000u), __uint_as_float(xw[g].w << 16), __uint_as_float(xw[g].w & 0xffff0000u)};
                v[2 * jj] = x0 * ALPHA + gp[0] * f0; v[2 * jj + 1] = x1 * ALPHA + gp[1] * f1;
                s += ((v[2 * jj][0] + v[2 * jj][1]) + (v[2 * jj][2] + v[2 * jj][3])) + ((v[2 * jj + 1][0] + v[2 * jj + 1][1]) + (v[2 * jj + 1][2] + v[2 * jj + 1][3])); }
            asm volatile("" ::: "memory"); }
        const float mean = wave_sum(s) * (1.f / DM); float s2 = 0.f;
#pragma unroll
        for (int j = 0; j < 8; ++j) { v[j] = v[j] - mean; s2 += (v[j][0] * v[j][0] + v[j][1] * v[j][1]) + (v[j][2] * v[j][2] + v[j][3] * v[j][3]); }
        const float rstd = 1.f / sqrtf(wave_sum(s2) * (1.f / DM) + LN_EPS); s = 0.f;
#pragma unroll
        for (int j = 0; j < 8; ++j) { const int ci = 2 * (lane + 64 * (j >> 1)) + (j & 1);
            v[j] = v[j] * rstd * P_lg[ci] + P_lb[ci]; s += (v[j][0] + v[j][1]) + (v[j][2] + v[j][3]); }
        if (l == NLAYER - 1) {
#pragma unroll
            for (int j = 0; j < 8; ++j) ((f32x4*)dst)[2 * (lane + 64 * (j >> 1)) + (j & 1)] = v[j];
        } else {
#pragma unroll
            for (int jj = 0; jj < 4; ++jj) ((u32x4*)dstb)[lane + 64 * jj] = (u32x4){pk_bf16(v[2 * jj][0], v[2 * jj][1]), pk_bf16(v[2 * jj][2], v[2 * jj][3]), pk_bf16(v[2 * jj + 1][0], v[2 * jj + 1][1]), pk_bf16(v[2 * jj + 1][2], v[2 * jj + 1][3])}; }
        if (l + 1 < NLAYER) {
            bf16* A1 = (bf16*)(wsb() + WS_A1);
            const float mean1 = wave_sum(s) * (1.f / DM); float q2 = 0.f;
#pragma unroll
            for (int j = 0; j < 8; ++j) { v[j] = v[j] - mean1; q2 += (v[j][0] * v[j][0] + v[j][1] * v[j][1]) + (v[j][2] * v[j][2] + v[j][3] * v[j][3]); }
            const float rstd1 = 1.f / sqrtf(wave_sum(q2) * (1.f / DM) + LN_EPS);
#pragma unroll
            for (int jj = 0; jj < 4; ++jj) { const int ci = 2 * (lane + 64 * jj);
                const f32x4 o0 = v[2 * jj] * rstd1 * (P_sc[mi * 512 + ci] + 1.f) + P_sh[mi * 512 + ci], o1 = v[2 * jj + 1] * rstd1 * (P_sc[mi * 512 + ci + 1] + 1.f) + P_sh[mi * 512 + ci + 1];
#if FP8_IN
                int wa = 0, wb = 0; wa = cvt2_fp8(o0[0], o0[1], wa, false); wa = cvt2_fp8(o0[2], o0[3], wa, true);
                wb = cvt2_fp8(o1[0], o1[1], wb, false); wb = cvt2_fp8(o1[2], o1[3], wb, true);
                ((u32x2*)((unsigned char*)A1 + (size_t)r * DM))[lane + 64 * jj] = (u32x2){(unsigned)wa, (unsigned)wb}; } }
#else
                u32x4 w; w.x = pk_bf16(o0[0], o0[1]); w.y = pk_bf16(o0[2], o0[3]); w.z = pk_bf16(o1[0], o1[1]); w.w = pk_bf16(o1[2], o1[3]);
                ((u32x4*)(A1 + (size_t)r * DM))[lane + 64 * jj] = w; } }
#endif
    }
}

#ifndef PROBE_SUB
#define PROBE_SUB 7
#endif
#define CONV_GRP(b) (((b) >> 3) & 3)
#ifndef PROBE_NOSTORE
#define PROBE_NOSTORE 0
#endif
constexpr int PH_PER_LAYER = 10, N_PHASES = 1 + NLAYER * PH_PER_LAYER;
__global__ void __launch_bounds__(NTHR, 2) mk_fwd(Args a) {
    extern __shared__ __attribute__((aligned(16))) unsigned char lds_raw[];
    LAS unsigned char* lds = (LAS unsigned char*)lds_raw;
    const int wave = __builtin_amdgcn_readfirstlane((int)threadIdx.x >> 6);
#define tid (wave * 64 + lane_now())
#define lane lane_now()
    const int G0 = gridDim.x, bid0 = blockIdx.x;
    volatile LAS unsigned* LW = (volatile LAS unsigned*)(lds + LDSCTL_OFF);
    for (int u = tid; u < LDSCTL_BYTES / 4; u += NTHR) LW[u] = 0u;
    __syncthreads();
    unsigned* ctl = (unsigned*)(wsb() + WS_CTL);
    XcdBarrier bar; bar.bar = ctl + CW_BAR + a.li * XCD_BAR_WORDS; bar.x = 0; bar.st = nullptr;
    const bool multi = (a.ph_hi - a.ph_lo) > 1;
    if (multi) bar = xcd_barrier_post(ctl + CW_BAR + a.li * XCD_BAR_WORDS, LW + LW_BAR, wave == 0 && lane_now() == 0);
    const int lo = a.ph_lo, hi = a.ph_hi;
#ifndef PHMASK
#define PHMASK 0x7ff
#endif
#define PHC(j) ((PHMASK >> (j)) & 1)
#define IN(k) (lo <= (k) && (k) < hi)
#define SEAM(k) do { if (IN(k) && IN((k) + 1)) xcd_barrier(bar, wave == 0 && lane_now() == 0); } while (0)
#define FRESH() int G = G0, bid = bid0; asm volatile("" : "+s"(G), "+s"(bid))

    if (PHC(0) && IN(0)) { FRESH(); p0_prologue(a, lds, G, bid, tid, wave, lane); }
    SEAM(0);

    for (int l = 0; l < NLAYER; ++l) {
        const int pb = 1 + l * PH_PER_LAYER;
        if (l == 0) {
        if (PHC(1) && IN(pb + 0)) { FRESH(); p_ln1(a, l, G, bid, wave, lane); for (int fl = 0; fl < NLAYER; ++fl) p_filt(fl, G, bid, wave, lane); }
        SEAM(pb + 0);
        }
        if (PHC(2) && IN(pb + 1)) { FRESH();
#if FP8_IN
            constexpr int RSI = DM; constexpr bool F8I = true; const float invI = 1.0f / W8_SCALE;
            const bf16* WinT = (const bf16*)(wsb() + WS_WINT + (size_t)l * DIN * DM); const bf16* A1 = (const bf16*)(wsb() + WS_A1); const bf16* WinR = (const bf16*)(wsb() + WS_WINT + (size_t)l * DIN * DM + (size_t)NHY * DM);
#else
            constexpr int RSI = 2 * DM; constexpr bool F8I = false; const float invI = 1.0f;
            const bf16* WinT = (const bf16*)(wsb() + WS_WINT) + (size_t)l * DIN * DM; const bf16* A1 = (const bf16*)(wsb() + WS_A1); const bf16* WinR = WinT + (size_t)NHY * DM;
#endif
            {   pg8::PlainSched<RSI> S; S.T.init(NHY / 256, M / 256, G, bid); S.A = WinT; S.Bt = A1; S.skipctx = 0; S.lw = (const volatile LAS int*)(LW + LW_MISC + 100);
                pg8::EpiBf16 E{(bf16*)(wsb() + WS_HYT), M, invI};
                pg8::gemm_phase<RSI, F8I, pg8::EpiBf16, pg8::PlainSched<RSI>, true>(lds, S, E, wave); }
            {   const int na = (NHY / 256) * (M / 256);
                pg8::PlainSched<RSI> S; S.T.init(M / 256, NREST / 256, G, (bid + G - (na % G)) % G); S.A = A1; S.Bt = WinR; S.skipctx = 0; S.lw = (const volatile LAS int*)(LW + LW_MISC + 100);
                pg8::EpiU E{(bf16*)(wsb() + WS_U), (const float*)(wsb() + WS_ROPE), invI};
                pg8::gemm_phase<RSI, F8I, pg8::EpiU, pg8::PlainSched<RSI>, true>(lds, S, E, wave); }
        }
        SEAM(pb + 1);
        if (PHC(3) && IN(pb + 2)) { FRESH();
#ifndef MIX1SEL
#define MIX1SEL 7
#endif
#ifndef PROBE_SUB
#define PROBE_SUB 7
#endif
            const bool rep = (a.li > 0) && (lo == pb + 2);
            if (CONV_GRP(bid) == 0) moe_conv(l, lds, G, bid, wave, lane);
            if ((MIX1SEL & 1) && (!rep || (PROBE_SUB & 1))) for (int c = bid; c < HYW; c += G) hyena_lat_unit(a, l, c, lds, tid, wave, lane);
            if ((MIX1SEL & 2) && (!rep || (PROBE_SUB & 2))) for (int c = bid; c < (l == NLAYER - 1 ? 0 : HYW); c += G) hyena_ctx_unit(a, l, c, lds, tid, wave, lane);
            if ((MIX1SEL & 4) && (!rep || (PROBE_SUB & 4))) for (int u = bid; u < NB * 8 * LRU_NCH; u += G) lru_unit<1>(a, l, u, lds, tid, wave, lane);
            if (CONV_GRP(bid) == 1) moe_conv(l, lds, G, bid, wave, lane);
        }
        if (PHC(4) && IN(pb + 3)) { FRESH();
            const bf16* U = (const bf16*)(wsb() + WS_U); float* OATT = (float*)(wsb() + WS_OATT);
#ifndef MIX2SEL
#define MIX2SEL 3
#endif
            if (MIX2SEL & 1) for (int u = bid; u < 512 + (l == NLAYER - 1 ? 0 : 32); u += G) {
                if (u >= G && u < 2 * G && CONV_GRP(bid) == 2) moe_conv(l, lds, G, bid, wave, lane);
                int b, h, mp, vh, qrow, seq;
                if (u < 512) { const int qb = (u >> 3) & 15; vh = (u >> 7) & 1; mp = u & 1; h = (u >> 1) & 3; b = u >> 8; qrow = b * RB + CTXL + qb * 256; seq = RB; }
                else { const int v = u - 512; vh = v & 1; mp = (v >> 1) & 1; h = (v >> 2) & 3; b = v >> 4; qrow = b * RB; seq = CTXL; }
                const bf16* Qb = U + (size_t)qrow * NREST + UC_Q + (h * 2 + mp) * 128;
                const bf16* Kh = U + (size_t)(b * RB) * NREST + UC_K + (h * 2 + mp) * 128;
                const bf16* Vh = U + (size_t)(b * RB) * NREST + UC_V + h * 256 + vh * 128;
                float* Ob = OATT + ((size_t)mp * M + qrow) * 1024 + h * 256 + vh * 128;
                att::attn_dense_body<NREST, NREST, 1024>(Qb, Kh, Vh, Ob, seq, (char*)lds_raw, wave);
            }
            if (CONV_GRP(bid) == 3) moe_conv(l, lds, G, bid, wave, lane);
        }
        SEAM(pb + 3);
        if (PHC(5) && IN(pb + 4)) { FRESH(); const bool rep5 = (a.li > 0) && (lo == pb + 4); const int sub5 = rep5 ? PROBE_SUB : 7; p_mix3(a, l, lds, G, bid, tid, wave, lane, sub5);
            if (sub5 & 4) {
                if (l == NLAYER - 1) { for (int v = bid; v < NB * 8 * (LRU_NCH - 2); v += G) lru_unit<2>(a, l, (v / (LRU_NCH - 2)) * LRU_NCH + 2 + v % (LRU_NCH - 2), lds, tid, wave, lane); }
                else for (int u = bid; u < NB * 8 * LRU_NCH; u += G) lru_unit<2>(a, l, u, lds, tid, wave, lane); } }
        SEAM(pb + 4);
        if (PHC(6) && IN(pb + 5)) { FRESH();
            const int last = (l == NLAYER - 1);
            if (bid == 0 && tid < 64 && !((a.li > 0) && (lo == pb + 5) && !(PROBE_SUB & 4))) ((unsigned*)(wsb() + WS_CTL))[CW_CNT + (64 * l + tid) * CNT_ST] = 0u;
#if FP8_OUT
            constexpr int RSO = DM; constexpr bool F8O = true; const float invO = 1.0f / (W8_SCALE * MIX8_SCALE); const bf16* WoT = (const bf16*)(wsb() + WS_WOUTT + (size_t)l * DM * DM);
#else
            constexpr int RSO = 2 * DM; constexpr bool F8O = false; const float invO = 1.0f; const bf16* WoT = (const bf16*)(wsb() + WS_WOUTT) + (size_t)l * DM * DM;
#endif
            pg8::PlainSched<RSO> S; S.T.init(last ? 32 : M / 256, DM / 256, G, bid); S.skipctx = last; S.lw = (const volatile LAS int*)(LW + LW_MISC + 100); S.A = (const bf16*)(wsb() + WS_MIX); S.Bt = WoT;
            pg8::EpiOut E{l, invO};
            pg8::gemm_phase<RSO, F8O, pg8::EpiOut, pg8::PlainSched<RSO>, true>(lds, S, E, wave);
        }
        SEAM(pb + 5);
        if (PHC(7) && IN(pb + 6)) { FRESH(); const bool rep2 = (a.li > 0) && (lo == pb + 5); p_ln2(a, l, lds, G, bid, tid, wave, lane, rep2 ? PROBE_SUB : 7); }
        SEAM(pb + 6);
        if (IN(pb + 7) || IN(pb + 8)) {
            const unsigned* cnt = (const unsigned*)(wsb() + WS_CTL) + CW_CNT + 64 * l * CNT_ST;
            if (tid < NEXP) LW[LW_MISC + tid] = __hip_atomic_load(cnt + tid * CNT_ST, RLX_AGENT);
            __syncthreads();
            if (tid == 0) { int acc = 0, nf = 0, nt = 0;
                for (int e = 0; e < NEX1; ++e) { LW[LW_TPRE + e] = (unsigned)acc; LW[LW_FPRE + e] = (unsigned)nf; const int c = (e < NEXP) ? (int)LW[LW_MISC + e] : (l == NLAYER - 1 ? NB * SEQ : M); const int t = (c + 255) / 256;
                    acc += t; if (t > 0) { nf += t - 1; LW[LW_FPRE + NEX1 + 2 + nt] = (unsigned)e; ++nt; } }
                LW[LW_TPRE + NEX1] = (unsigned)acc; LW[LW_FPRE + NEX1] = (unsigned)nf; LW[LW_FPRE + NEX1 + 1] = (unsigned)nt; }
            __syncthreads();
        }
        if (PHC(8) && IN(pb + 7)) { FRESH();
            pg8::MoeSched<DM, 4, true> S; S.tpre = (const volatile LAS int*)(LW + LW_TPRE); S.fpre = (const volatile LAS int*)(LW + LW_FPRE); S.G = G; S.c = bid; S.A = wsb() + WS_H2; S.Bt = wsb() + WS_W1T + (size_t)l * NEX1 * 1024 * DM;
            S.ltok = (const int*)(wsb() + WS_LIST); S.cnt = (const volatile LAS int*)(LW + LW_MISC); S.latent_only = (l == NLAYER - 1);
            pg8::EpiMoe1 E{wsb() + WS_ACT, 1.0f / W8_SCALE};
            pg8::gemm_phase<DM, true, pg8::EpiMoe1, pg8::MoeSched<DM, 4, true>, true>(lds, S, E, wave);
        }
        SEAM(pb + 7);
        if (PHC(9) && IN(pb + 8)) { FRESH();
#ifndef MOE2_STAGGER
#define MOE2_STAGGER 0
#endif
            if (MOE2_STAGGER > 0 && ((bid >> 3) & 1)) { for (int i = 0; i < MOE2_STAGGER; ++i) __builtin_amdgcn_s_sleep(127); }
            pg8::MoeSched<DEXP, 8, false> S; S.tpre = (const volatile LAS int*)(LW + LW_TPRE); S.fpre = (const volatile LAS int*)(LW + LW_FPRE); S.G = G; S.c = bid; S.A = wsb() + WS_ACT; S.Bt = wsb() + WS_W2T + (size_t)l * NEX1 * DM * DEXP;
            S.ltok = nullptr; S.cnt = (const volatile LAS int*)(LW + LW_MISC); S.latent_only = (l == NLAYER - 1);
            const int* ltok = (const int*)(wsb() + WS_LIST);
            pg8::EpiMoe2 E{(bf16*)(wsb() + WS_YG), ltok + (size_t)NEXP * LCAP, ltok + (size_t)2 * NEXP * LCAP, (const volatile LAS int*)(LW + LW_MISC), (l == NLAYER - 1), 1.0f / W8_SCALE, (PROBE_NOSTORE == 2) ? ((hi == pb + 9) ? 2 : 0) : (PROBE_NOSTORE == 3) ? (((a.li > 0) && (lo == pb + 8)) ? 3 : 0) : (PROBE_NOSTORE && (a.li > 0) && (lo == pb + 8))};
            pg8::gemm_phase<DEXP, true, pg8::EpiMoe2, pg8::MoeSched<DEXP, 8, false>, true>(lds, S, E, wave);
        }
        SEAM(pb + 8);
        if (PHC(10) && IN(pb + 9)) { FRESH(); p_ffnln(a, l, lds, G, bid, wave, lane); }
        SEAM(pb + 9);
    }
#undef IN
#undef SEAM
#undef tid
#undef lane
}

extern "C" void kernel_launch(void* const* d_in, const int* in_sizes, int n_in, void* d_out, int out_size, void* d_ws, size_t ws_size, hipStream_t stream) {
    static int grid = 0;
    if (grid == 0) {
        if (n_in != 36 || out_size != NB * SEQ * DM || ws_size < WS_END) { fprintf(stderr, "kernel_launch: built for 36 inputs, %d outputs, >= %zu bytes of workspace; got n_in %d, out %d, ws %zu; nothing launched\n", NB * SEQ * DM, (size_t)WS_END, n_in, out_size, ws_size); grid = -1; return; }
        int dev = 0, cus = 0, per_cu = 0;
        if (hipGetDevice(&dev) != hipSuccess || hipDeviceGetAttribute(&cus, hipDeviceAttributeMultiprocessorCount, dev) != hipSuccess) { fprintf(stderr, "kernel_launch: device query failed\n"); grid = -1; return; }
        if (hipFuncSetAttribute((const void*)mk_fwd, hipFuncAttributeMaxDynamicSharedMemorySize, LDS_BYTES) != hipSuccess) { fprintf(stderr, "kernel_launch: hipFuncSetAttribute(%d B LDS) failed\n", LDS_BYTES); grid = -1; return; }
        if (hipOccupancyMaxActiveBlocksPerMultiprocessor(&per_cu, (const void*)mk_fwd, NTHR, LDS_BYTES) != hipSuccess || per_cu < 1) { fprintf(stderr, "kernel_launch: occupancy query says %d blocks per CU\n", per_cu); (void)hipGetLastError(); grid = -1; return; }
        grid = cus;
    }
    if (grid < 0) return;
    if (hipMemsetAsync((char*)d_ws + WS_CTL, 0, CTL_ZERO_BYTES, stream) != hipSuccess) { fprintf(stderr, "kernel_launch: memset failed\n"); return; }
    Args a{};
    for (int i = 0; i < 36; ++i) a.in[i] = (const float*)d_in[i];
    a.out = (float*)d_out; a.ws = (unsigned char*)d_ws;
#if defined(PROBE_REP)
    {   const int j = PROBE_REP; int lo[3], hi[3], n;
        if (j == 0) { lo[0] = 0; hi[0] = 1; lo[1] = 0; hi[1] = N_PHASES; n = 2; }
        else {
#ifdef PROBE_REP_HI
            const int j1 = PROBE_REP_HI;
#else
            const int j1 = j;
#endif
            lo[0] = 0; hi[0] = j1 + 1; lo[1] = j; hi[1] = PH_PER_LAYER + j1 + 1; lo[2] = PH_PER_LAYER + j; hi[2] = N_PHASES; n = 3; }
        for (int i = 0; i < n; ++i) { a.ph_lo = lo[i]; a.ph_hi = hi[i]; a.li = i; hipLaunchKernelGGL(mk_fwd, dim3(grid), dim3(NTHR), LDS_BYTES, stream, a); } }
#elif MK_N_LAUNCHES == 1
    a.ph_lo = 0; a.ph_hi = N_PHASES;
    hipLaunchKernelGGL(mk_fwd, dim3(grid), dim3(NTHR), LDS_BYTES, stream, a);
#else
    for (int p = 0; p < N_PHASES; ++p) { a.ph_lo = p; a.ph_hi = p + 1; hipLaunchKernelGGL(mk_fwd, dim3(grid), dim3(NTHR), LDS_BYTES, stream, a); }
#endif
    const hipError_t le = hipPeekAtLastError();
    if (le != hipSuccess) fprintf(stderr, "kernel_launch: launch failed: %s\n", hipGetErrorName(le));
}
```

```cpp
#include <hip/hip_runtime.h>
#include <cstdio>
#include <cstdint>

#define LAS __attribute__((address_space(3)))
#define GAS __attribute__((address_space(1)))
typedef unsigned short bf16;
typedef short bf16x8 __attribute__((ext_vector_type(8)));
typedef short s16x4 __attribute__((ext_vector_type(4)));
typedef float f32x4 __attribute__((ext_vector_type(4)));
typedef float f32x2 __attribute__((ext_vector_type(2)));
typedef float f32x16 __attribute__((ext_vector_type(16)));
typedef unsigned u32x4 __attribute__((ext_vector_type(4)));
typedef unsigned u32x2 __attribute__((ext_vector_type(2)));

#ifndef FP8_OUT
#define FP8_OUT 1
#endif
constexpr float MIX8_SCALE = 1.0f;
#ifndef FP8_IN
#define FP8_IN 0
#endif
#ifndef F8_HY
#define F8_HY 1
#endif
#ifndef F8_C0
#define F8_C0 (FP8_IN ? 0 : 1024)
#endif
#ifndef F8_C1
#define F8_C1 4096
#endif
#define NEED_A1B (!(F8_HY) || (F8_C1 - F8_C0) < 4096)
#define NEED_A1F ((F8_HY) || (F8_C1 > F8_C0))
#ifndef ATT_QK8
#define ATT_QK8 1
#endif
#ifndef ATT_PV8
#define ATT_PV8 1
#endif
#ifndef ATT_NV
#define ATT_NV 2
#endif
#ifndef ATT_STAG
#define ATT_STAG 0
#endif
#ifndef YG_F8
#define YG_F8 1
#endif
constexpr float YG8_SCALE = 16.0f;
#ifndef ATT_DMA
#define ATT_DMA 1
#endif
#ifndef ATT_FASTEXP
#define ATT_FASTEXP 0
#endif
#ifndef PROBE_DEG
#define PROBE_DEG 0
#endif
#ifndef ATT_PIPE
#define ATT_PIPE 0
#endif
#ifndef ATT_PAIR
#define ATT_PAIR 1
#endif
#ifndef MK_N_LAUNCHES
#define MK_N_LAUNCHES 1
#ifndef YG_NT
#define YG_NT 0
#endif
#endif

constexpr int NB = 2, SEQ = 4096, CTXL = 256, DM = 2048, NLAYER = 2, GRIDW = 64;
constexpr int RB = CTXL + SEQ;
constexpr int M = NB * RB;
constexpr int DIN = 5632, NHY = 1536, NREST = 4096;
constexpr int UC_GATE = 0, UC_REC = 512, UC_Q = 1024, UC_K = 2048, UC_V = 3072;
constexpr int HYW = 512, NEXP = 64, NEX1 = 65, TOPK = 8, DEXP = 512, LCAP = M;
constexpr int LRU_CH = 128, LRU_NCH = RB / LRU_CH;
constexpr float LN_EPS = 1e-5f, ALPHA = 1.41421356237309515f, ROUTED_SCALE = 2.5f;
constexpr int NWAVES = 8, NTHR = 512;
constexpr int ACT_TILES_MAX = (M * TOPK) / 256 + NEXP + M / 256;

constexpr size_t al256(size_t x) { return (x + 255) / 256 * 256; }
constexpr size_t WS_CTL = 0, CTL_ZERO_BYTES = 1u << 20;
constexpr size_t WS_MOD   = CTL_ZERO_BYTES;
constexpr size_t WS_ROPE  = WS_MOD + al256((size_t)NLAYER * 3 * 6 * DM * 4);
constexpr size_t WS_HIDB  = WS_ROPE + al256(64 * 32 * 8);
constexpr size_t WS_W3T   = WS_HIDB + al256((size_t)NLAYER * RB * 64 * 2);
constexpr size_t WS_FILT  = WS_W3T + al256((size_t)NLAYER * 2048 * 64 * 2);
constexpr size_t WS_RWT   = WS_FILT + al256((size_t)NLAYER * 2048 * RB * 4);
constexpr size_t WS_TW    = WS_RWT + al256((size_t)NLAYER * 2 * NEXP * DM * 2);
constexpr size_t WS_LAMS  = WS_TW + 65536;
constexpr size_t WS_LRUAGG = WS_LAMS + 256;
constexpr size_t WS_LIST  = WS_LRUAGG + al256((size_t)NB * 2 * LRU_NCH * 512 * 8);
constexpr size_t WS_WINT  = WS_LIST + al256((size_t)3 * NEXP * LCAP * 4);
constexpr size_t WS_WOUTT = WS_WINT + al256((size_t)NLAYER * DIN * DM * 2);
constexpr size_t WS_W1T   = WS_WOUTT + al256((size_t)NLAYER * DM * DM * 2);
constexpr size_t WS_W2T   = WS_W1T + al256((size_t)NLAYER * NEX1 * 1024 * DM * 2);
constexpr size_t WS_A1    = WS_W2T + al256((size_t)NLAYER * NEX1 * DM * DEXP * 2);
constexpr size_t WS_HYT   = WS_A1 + al256((size_t)M * DM * 2);
constexpr size_t WS_U     = WS_HYT + al256((size_t)NHY * M * 2);
constexpr size_t WS_YHT   = WS_U + al256((size_t)M * NREST * 2);
constexpr size_t WS_OATT  = WS_YHT + al256((size_t)HYW * M * 2);
constexpr size_t WS_MIX   = WS_OATT + al256((size_t)2 * M * 1024 * 4);
constexpr size_t WS_RBUF  = WS_MIX + al256((size_t)M * DM * 2);
constexpr size_t WS_XA    = WS_RBUF + al256((size_t)M * DM * 4);
constexpr size_t WS_XB    = WS_XA + al256((size_t)M * DM * 4);
constexpr size_t WS_H2    = WS_XB + al256((size_t)M * DM * 4);
constexpr size_t WS_H2F   = WS_H2 + al256((size_t)M * DM * 2);
constexpr size_t WS_ACT   = WS_H2F + al256((size_t)M * DM * 4);
constexpr size_t WS_YG    = WS_ACT + al256((size_t)ACT_TILES_MAX * 256 * DEXP * 2);
constexpr size_t WS_END   = WS_YG + al256((size_t)M * 9 * DM * 2);
constexpr size_t WS_QK8   = WS_ACT + al256((size_t)M * DM);
constexpr size_t WS_VT8   = WS_QK8 + al256((size_t)M * DM);
constexpr size_t WS_A1F   = WS_ACT;
constexpr int CW_TMO = 0;
constexpr int CW_CNT = 16384, CNT_ST = 64;
constexpr int CW_BAR = 4096;

constexpr int RING_BYTES = 143360;
constexpr int LDSCTL_OFF = RING_BYTES, LDSCTL_BYTES = 2048;
constexpr int ULIST_OFF = 131072 + 4096;
constexpr int LDS_BYTES = RING_BYTES + LDSCTL_BYTES;
constexpr int LW_BAR = 0, LW_TPRE = 16, LW_MISC = 128, LW_FPRE = 256;

#define RLX_AGENT __ATOMIC_RELAXED, __HIP_MEMORY_SCOPE_AGENT
#define LDS_WAIT() asm volatile("s_waitcnt lgkmcnt(0)" ::: "memory")
#define VM_WAIT() asm volatile("s_waitcnt vmcnt(0)" ::: "memory")

__device__ __forceinline__ unsigned pk_bf16(float lo, float hi) { unsigned r; asm volatile("v_cvt_pk_bf16_f32 %0, %1, %2" : "=v"(r) : "v"(lo), "v"(hi)); return r; }
__device__ __forceinline__ float bf2f(bf16 b) { return __uint_as_float(((unsigned)b) << 16); }
__device__ __forceinline__ bf16 f2bf(float f) { return (bf16)(pk_bf16(f, 0.f) & 0xffffu); }
template <int O> __device__ __forceinline__ float xor_get(float v) {
    if constexpr (O < 32) return __int_as_float(__builtin_amdgcn_ds_swizzle(__float_as_int(v), (O << 10) | 0x1F));
    else { const auto rr = __builtin_amdgcn_permlane32_swap(__float_as_uint(v), __float_as_uint(v), false, false);
        const unsigned own = __float_as_uint(v); return __uint_as_float(rr[0] == own ? rr[1] : rr[0]); }
}
#define SHFL_XOR(v, o) xor_get<(o)>(v)
__device__ __forceinline__ float half_sum(float v) { const auto rr = __builtin_amdgcn_permlane32_swap(__float_as_uint(v), __float_as_uint(v), false, false); return __uint_as_float(rr[0]) + __uint_as_float(rr[1]); }
__device__ __forceinline__ float wave_sum(float v) {
    v += xor_get<1>(v); v += xor_get<2>(v); v += xor_get<4>(v); v += xor_get<8>(v); v += xor_get<16>(v);
    { const auto rr = __builtin_amdgcn_permlane32_swap(__float_as_uint(v), __float_as_uint(v), false, false); v = __uint_as_float(rr[0]) + __uint_as_float(rr[1]); }
    return v;
}
__device__ __forceinline__ float wave_max(float v) {
    v = fmaxf(v, xor_get<1>(v)); v = fmaxf(v, xor_get<2>(v)); v = fmaxf(v, xor_get<4>(v)); v = fmaxf(v, xor_get<8>(v)); v = fmaxf(v, xor_get<16>(v));
    { const auto rr = __builtin_amdgcn_permlane32_swap(__float_as_uint(v), __float_as_uint(v), false, false); v = fmaxf(__uint_as_float(rr[0]), __uint_as_float(rr[1])); }
    return v;
}
__device__ __forceinline__ float fast_exp(float x) { return __builtin_amdgcn_exp2f(x * 1.4426950408889634f); }
__device__ __forceinline__ float sigm(float x) { return __builtin_amdgcn_rcpf(1.f + fast_exp(-x)); }
__device__ __forceinline__ float silu_f(float x) { return x * sigm(x); }
__device__ __forceinline__ float gelu_tanh(float x) { const float u = 0.7978845608028654f * (x + 0.044715f * x * x * x); const float e = fast_exp(2.f * u); return 0.5f * x * (2.f - 2.f * __builtin_amdgcn_rcpf(e + 1.f)); }
__device__ __forceinline__ float sin_rev(float r) { r -= rintf(r); return __builtin_amdgcn_sinf(r); }
__device__ __forceinline__ float cos_rev(float r) { r -= rintf(r); return __builtin_amdgcn_cosf(r); }
__device__ __forceinline__ float sin_rad(float x) { return sin_rev(x * 0.15915494309189535f); }

__device__ __forceinline__ int cvt2_fp8(float a, float b, int old, bool hi) { a = fminf(fmaxf(a, -448.f), 448.f); b = fminf(fmaxf(b, -448.f), 448.f); return hi ? __builtin_amdgcn_cvt_pk_fp8_f32(a, b, old, true) : __builtin_amdgcn_cvt_pk_fp8_f32(a, b, old, false); }
__device__ __forceinline__ int lane_now() { int l; asm volatile("v_mbcnt_lo_u32_b32 %0, -1, 0\n\tv_mbcnt_hi_u32_b32 %0, -1, %0" : "=v"(l)); return l; }
__device__ __forceinline__ int row_mod(int r) { const int b = r >= RB ? 1 : 0; const int p = r - b * RB; return p < CTXL ? 2 : b; }
__device__ __forceinline__ const float* xin_row(const float* x, const float* ctx, int r) { const int b = r >= RB ? 1 : 0; const int p = r - b * RB; return p < CTXL ? ctx + ((size_t)b * CTXL + p) * DM : x + ((size_t)b * SEQ + (p - CTXL)) * DM; }

#define XB_TMO      128
#define XB_XCNT(j)  (256  + 64 * (j))
#define XB_XSUB(j)  (1280 + 64 * (j))
#define XB_XGEN(j)  (2304 + 64 * (j))
#define XB_TOP      3328
#define XB_TOPGEN   3392
#define XCD_BAR_WORDS 3456
#define XB_SPIN_CAP (1u << 18)
__device__ __forceinline__ unsigned xb_ld(unsigned* p)              { return __hip_atomic_load(p, __ATOMIC_RELAXED, __HIP_MEMORY_SCOPE_AGENT); }
__device__ __forceinline__ unsigned xb_add(unsigned* p, unsigned v) { return __hip_atomic_fetch_add(p, v, __ATOMIC_RELAXED, __HIP_MEMORY_SCOPE_AGENT); }
__device__ __forceinline__ unsigned xb_xcc_id() { return (unsigned)__builtin_amdgcn_s_getreg((3 << 11) | 20) & 0xFu; }
#define XB_SPIN(cond, bar) do { unsigned _sp = 0; while (cond) { __builtin_amdgcn_s_sleep(1); \
    if ((++_sp & 255u) == 0u) { if (xb_ld(&(bar)[XB_TMO])) break; if (_sp > XB_SPIN_CAP) { atomicAdd(&(bar)[XB_TMO], 1u); break; } } } } while (0)
struct XcdBarrier { unsigned* bar; unsigned x; volatile LAS unsigned* st; };
__device__ __forceinline__ XcdBarrier xcd_barrier_post(unsigned* bar, volatile LAS unsigned* st, bool t0) {
    XcdBarrier b; b.bar = bar; b.x = xb_xcc_id(); b.st = st;
    if (t0) (void)xb_add(&bar[XB_XCNT(b.x)], 1u);
    return b;
}
__device__ __forceinline__ void xcd_barrier_complete(unsigned* bar, unsigned x, unsigned& nloc, unsigned& nx) {
    const unsigned G = gridDim.x * gridDim.y * gridDim.z;
    unsigned sum, cnt, mine, sp = 0u;
    for (;;) {
        sum = 0u; cnt = 0u; mine = 0u;
#pragma unroll
        for (unsigned j = 0; j < 16; ++j) { const unsigned c = xb_ld(&bar[XB_XCNT(j)]); sum += c; cnt += (c > 0u) ? 1u : 0u; mine = (j == x) ? c : mine; }
        if (sum == G) break;
        __builtin_amdgcn_s_sleep(1);
        if ((++sp & 255u) == 0u) { if (xb_ld(&bar[XB_TMO])) break; if (sp > XB_SPIN_CAP) { atomicAdd(&bar[XB_TMO], 1u); break; } }
    }
    nloc = mine > 0u ? mine : 1u; nx = cnt > 0u ? cnt : 1u;
}
__device__ __forceinline__ void xcd_barrier(const XcdBarrier& b, bool t0) {
    asm volatile("s_waitcnt vmcnt(0)" ::: "memory");
    __syncthreads();
    if (t0) {
        unsigned* bar = b.bar;
        __builtin_amdgcn_s_waitcnt(0);
        unsigned nloc = b.st[0], nx = b.st[1];
        if (nloc == 0u) { xcd_barrier_complete(bar, b.x, nloc, nx); b.st[0] = nloc; b.st[1] = nx; }
        const unsigned old = xb_add(&bar[XB_XSUB(b.x)], 1u);
        const unsigned gen = old / nloc;
        if (old + 1u == (gen + 1u) * nloc) {
            __builtin_amdgcn_fence(__ATOMIC_RELEASE, "agent");
            asm volatile("s_waitcnt vmcnt(0)" ::: "memory");
            const unsigned og = xb_add(&bar[XB_TOP], 1u);
            const unsigned tg = og / nx;
            if (og + 1u == (tg + 1u) * nx) xb_add(&bar[XB_TOPGEN], 1u);
            else XB_SPIN(xb_ld(&bar[XB_TOPGEN]) == tg, bar);
            __builtin_amdgcn_fence(__ATOMIC_ACQUIRE, "agent");
            xb_add(&bar[XB_XGEN(b.x)], 1u);
            asm volatile("s_waitcnt vmcnt(0)" ::: "memory");
        } else {
            XB_SPIN(xb_ld(&bar[XB_XGEN(b.x)]) == gen, bar);
            __builtin_amdgcn_fence(__ATOMIC_ACQUIRE, "agent");
            asm volatile("s_waitcnt vmcnt(0)" ::: "memory");
        }
    }
    __syncthreads();
}

__device__ __forceinline__ const float* inp(int i) { asm volatile("" : "+s"(i)); const GAS float* p = ((const GAS float* const*)__builtin_amdgcn_kernarg_segment_ptr())[i]; return (const float*)p; }
__device__ __forceinline__ unsigned char* wsb() { GAS unsigned char* p = ((GAS unsigned char* const*)__builtin_amdgcn_kernarg_segment_ptr())[37]; asm volatile("" : "+s"(p)); return (unsigned char*)p; }
__device__ __forceinline__ float* outb() { GAS float* p = ((GAS float* const*)__builtin_amdgcn_kernarg_segment_ptr())[36]; asm volatile("" : "+s"(p)); return (float*)p; }
enum InIdx { I_X = 0, I_C, I_CTX, I_CCTX, I_ADAW, I_ADAB, I_WIN, I_HYCW, I_HYCB, I_HYW1, I_HYB1, I_HYW2, I_HYB2, I_HYW3, I_HYFREQ, I_HYSKIP, I_LCW, I_LCB, I_LWA, I_LBA, I_LWX, I_LBX, I_LLAM,
             I_ATTLAM, I_SUBLN, I_WOUT, I_LNG, I_LNB, I_RW, I_RB, I_EWG, I_EWU, I_EWD, I_SWG, I_SWU, I_SWD };


namespace pg8 {
constexpr int BM = 256, BK = 64, HALF = 128, HTB = HALF * BK * 2, STAGE_BYTES = 8 * HTB, NXCD = 8, WGM = 8;
__host__ __device__ __forceinline__ int lds_byte(int r, int c) { const int st = (r >> 4) * 2 + (c >> 5), rr = r & 15, cc = c & 31, ob = rr * 64 + cc * 2; return st * 1024 + (ob ^ (((ob >> 9) & 1) << 5)); }
__host__ __device__ __forceinline__ void stage_rc(int b, int& R, int& C) { const int st = b / 1024, sb = b % 1024, swz = sb ^ (((sb >> 9) & 1) << 5); R = (st >> 1) * 16 + swz / 64; C = (st & 1) * 32 + (swz % 64) / 2; }
__host__ __device__ __forceinline__ int perm32(int rho) { const int n = rho >> 4, i = rho & 15; return 8 * (i >> 2) + 4 * n + (i & 3); }

struct Unit { int pm, pn, e, rt; };

struct TileOrder {
    int nM, nN, nwg, G, c;
    __device__ void init(int nM_, int nN_, int G_, int c_) { nM = nM_; nN = nN_; nwg = nM * nN; G = G_; c = c_; }
    __device__ bool tile(int i, int& pm, int& pn) const {
        const long L = (long)i * G + c; if (L >= nwg) return false;
        int wgid = (int)L; { const int q = nwg / NXCD, r = nwg % NXCD, xcd = wgid % NXCD, off = wgid / NXCD; wgid = (xcd < r ? xcd * (q + 1) : r * (q + 1) + (xcd - r) * q) + off; }
        const int nig = WGM * nN, gid = wgid / nig, fm = gid * WGM, gsz = (nM - fm) < WGM ? (nM - fm) : WGM;
        pm = fm + ((wgid % nig) % gsz); pn = (wgid % nig) / gsz; return true;
    }
};
template <int RS> struct PlainSched {
    TileOrder T; const bf16* A; const bf16* Bt; int skipctx; const volatile LAS int* lw; int pn_from = 1 << 20, pn_len = 0;
    __device__ bool next(int i, Unit& u) const { u.e = 0; u.rt = 0; int pm = 0, pn = 0; const bool ok = T.tile(i, pm, pn); if (skipctx) pm += 1 + (pm >= 16 ? 1 : 0); if (pn >= pn_from) pn += pn_len;
        int spm = __builtin_amdgcn_readfirstlane(pm), spn = __builtin_amdgcn_readfirstlane(pn), sok = __builtin_amdgcn_readfirstlane(ok ? 1 : 0); asm volatile("" : "+s"(spm), "+s"(spn), "+s"(sok));
        u.pm = spm; u.pn = spn; return sok != 0; }
    __device__ __forceinline__ bool half(const Unit&) const { return lw[0] != 0; }
    __device__ __forceinline__ const char* a_base(const Unit& u) const { return (const char*)A + (size_t)u.pm * 256 * RS; }
    __device__ __forceinline__ const char* b_base(const Unit& u) const { return (const char*)Bt + (size_t)u.pn * 256 * RS; }
    __device__ __forceinline__ void a_offs(const Unit&, unsigned (&o)[2][2], const int (&R)[2], const unsigned (&cb)[2]) const {
#pragma unroll
        for (int h = 0; h < 2; ++h)
#pragma unroll
            for (int i = 0; i < 2; ++i) o[h][i] = (unsigned)((h * HALF + R[i]) * RS) + cb[i];
    }
};

__device__ __forceinline__ unsigned cvt_pk_bf16(float lo, float hi) { unsigned r; asm volatile("v_cvt_pk_bf16_f32 %0, %1, %2" : "=v"(r) : "v"(lo), "v"(hi)); return r; }

typedef int i32x8 __attribute__((ext_vector_type(8)));
typedef int i32x4 __attribute__((ext_vector_type(4)));
__device__ __forceinline__ i32x8 cat8(bf16x8 lo, bf16x8 hi) { const i32x4 a = __builtin_bit_cast(i32x4, lo), b = __builtin_bit_cast(i32x4, hi); return __builtin_shufflevector(a, b, 0, 1, 2, 3, 4, 5, 6, 7); }
template <int RS, bool F8, class Epi, class Sched, bool ALIGN_EPI>
__device__ __forceinline__ void gemm_phase(LAS unsigned char* lds, const Sched& S, const Epi& E, int wid) {
    int lane_ = lane_now(); asm volatile("" : "+v"(lane_));
    const int lane = lane_, tid = wid * 64 + lane, wr = wid >> 2, wc = wid & 3, fr = lane & 15, fq = lane >> 4;
    constexpr int nt = RS / 128;
    int Rr[2]; unsigned cb[2], voffB[2];
#pragma unroll
    for (int i = 0; i < 2; ++i) { int R, C; stage_rc(tid * 16 + i * 8192, R, C); const int Rb = Epi::ADJ ? (64 * (R >> 5) + perm32(R & 31)) : (Epi::PERM ? ((R & ~31) + perm32(R & 31)) : R);
        Rr[i] = R; cb[i] = (unsigned)C * 2u; voffB[i] = (unsigned)(Rb * RS) + (unsigned)C * 2u; }
    constexpr size_t kstep = (size_t)(BK * 2);
    constexpr size_t hstep = (size_t)(Epi::ADJ ? 32 : HALF) * RS;
    const unsigned ldsw = (unsigned)wid * 1024u;
    const int aoff = lds_byte(wr * 64 + fr, fq * 8), boff = lds_byte(wc * 32 + fr, fq * 8);
#define PG8_SA(b, h) (((b) * 2 + (h)) * HTB)
#define PG8_SB(b, h) ((4 + (b) * 2 + (h)) * HTB)
#define PG8_STAGE(bufoff, gbase, voff) do { _Pragma("unroll") for (int _i = 0; _i < 2; ++_i) \
        __builtin_amdgcn_global_load_lds((const unsigned*)((const char*)(gbase) + (voff)[_i]), (LAS unsigned*)(lds + (bufoff) + ldsw + _i * 8192), 16, 0, 0); } while (0)
#define PG8_LDA(dst, b, h) do { _Pragma("unroll") for (int m = 0; m < 4; ++m) { \
        if constexpr (F8) dst##8[m] = cat8(*(const LAS bf16x8*)(lds + PG8_SA(b, h) + aoff + m * 2048), *(const LAS bf16x8*)(lds + PG8_SA(b, h) + aoff + m * 2048 + 1024)); \
        else { _Pragma("unroll") for (int k = 0; k < 2; ++k) dst[m][k] = *(const LAS bf16x8*)(lds + PG8_SA(b, h) + aoff + m * 2048 + k * 1024); } } } while (0)
#define PG8_LDB(dst, b, h) do { _Pragma("unroll") for (int n = 0; n < 2; ++n) { \
        if constexpr (F8) dst##8[n] = cat8(*(const LAS bf16x8*)(lds + PG8_SB(b, h) + boff + n * 2048), *(const LAS bf16x8*)(lds + PG8_SB(b, h) + boff + n * 2048 + 1024)); \
        else { _Pragma("unroll") for (int k = 0; k < 2; ++k) dst[n][k] = *(const LAS bf16x8*)(lds + PG8_SB(b, h) + boff + n * 2048 + k * 1024); } } } while (0)
#define PG8_MMA(ai, bj, At, Bt) do { __builtin_amdgcn_s_setprio(1); _Pragma("unroll") for (int m = 0; m < 4; ++m) _Pragma("unroll") for (int n = 0; n < 2; ++n) { \
        if constexpr (F8) acc[ai][bj][m][n] = __builtin_amdgcn_mfma_scale_f32_16x16x128_f8f6f4(Bt##8[n], At##8[m], acc[ai][bj][m][n], 0, 0, 0, 0, 0, 0); \
        else { _Pragma("unroll") for (int k = 0; k < 2; ++k) acc[ai][bj][m][n] = __builtin_amdgcn_mfma_f32_16x16x32_bf16(Bt[n][k], At[m][k], acc[ai][bj][m][n], 0, 0, 0); } } \
        __builtin_amdgcn_s_setprio(0); } while (0)
#define PG8_WAIT_V(n) asm volatile("s_waitcnt vmcnt(" #n ")" ::: "memory")
#define PG8_WAIT_L(n) asm volatile("s_waitcnt lgkmcnt(" #n ")" ::: "memory")
#define PG8_BAR __builtin_amdgcn_s_barrier()
#define PG8_SCHED __builtin_amdgcn_sched_barrier(0)
    Unit cur, nxt; int ui = 0;
    if (!S.next(0, cur)) return;
    f32x4 acc[2][2][4][2];
#pragma unroll
    for (int a = 0; a < 2; ++a)
#pragma unroll
        for (int b = 0; b < 2; ++b)
#pragma unroll
            for (int m = 0; m < 4; ++m)
#pragma unroll
                for (int n = 0; n < 2; ++n) acc[a][b][m][n] = (f32x4){0.f, 0.f, 0.f, 0.f};
    bf16x8 At[4][2], B0[2][2], B1[2][2]; i32x8 At8[4], B08[2], B18[2];
    const char* cA = S.a_base(cur); const char* cB = S.b_base(cur);
    unsigned co[2][2], no[2][2];
    S.a_offs(cur, co, Rr, cb);
    PG8_STAGE(PG8_SB(0, 0), cB, voffB); PG8_STAGE(PG8_SB(0, 1), cB + hstep, voffB); PG8_STAGE(PG8_SA(0, 0), cA, co[0]); PG8_STAGE(PG8_SA(0, 1), cA, co[1]);
    if (wr == 1) PG8_BAR;
    PG8_WAIT_V(2); PG8_BAR;
    PG8_STAGE(PG8_SB(1, 0), cB + kstep, voffB); PG8_STAGE(PG8_SA(1, 0), cA + kstep, co[0]); PG8_STAGE(PG8_SB(1, 1), cB + hstep + kstep, voffB);
    PG8_WAIT_V(6); PG8_BAR;
    for (;;) {
        E.prefetch(lds, cur, ui, wid, lane);
        const bool has_next = S.next(ui + 1, nxt);
        const char* nA = has_next ? S.a_base(nxt) : cA; const char* nB = has_next ? S.b_base(nxt) : cB;
        if (has_next) S.a_offs(nxt, no, Rr, cb);
        else {
#pragma unroll
            for (int h = 0; h < 2; ++h)
#pragma unroll
                for (int i = 0; i < 2; ++i) no[h][i] = co[h][i]; }
        const bool fullu = !S.half(cur);
#pragma unroll 1
        for (int t = 0; t < nt; t += 2) {
            const bool last = (t == nt - 2);
            const char* a1 = cA + (size_t)(t + 1) * kstep;
            const char* a2 = last ? nA : cA + (size_t)(t + 2) * kstep; const char* b2 = last ? nB : cB + (size_t)(t + 2) * kstep;
            const char* a3 = a2 + kstep; const char* b3 = b2 + kstep;
            unsigned o2[2][2];
#pragma unroll
            for (int h = 0; h < 2; ++h)
#pragma unroll
                for (int i = 0; i < 2; ++i) o2[h][i] = last ? no[h][i] : co[h][i];
            PG8_LDB(B0, 0, 0); PG8_LDB(B1, 0, 1); PG8_SCHED; PG8_LDA(At, 0, 0); PG8_STAGE(PG8_SA(1, 1), a1, co[1]);
            PG8_WAIT_V(8); PG8_WAIT_L(0); PG8_BAR; PG8_MMA(0, 0, At, B0); PG8_MMA(0, 1, At, B1); PG8_BAR; PG8_SCHED;
            PG8_LDA(At, 0, 1); PG8_STAGE(PG8_SB(0, 0), b2, voffB); PG8_STAGE(PG8_SB(0, 1), b2 + hstep, voffB); PG8_STAGE(PG8_SA(0, 0), a2, o2[0]);
            PG8_WAIT_V(8); PG8_WAIT_L(0); PG8_BAR; if (fullu) { PG8_MMA(1, 0, At, B0); PG8_MMA(1, 1, At, B1); } PG8_BAR; PG8_SCHED;
            PG8_LDB(B0, 1, 0); PG8_LDB(B1, 1, 1); PG8_SCHED; PG8_LDA(At, 1, 0); PG8_STAGE(PG8_SA(0, 1), a2, o2[1]);
            PG8_WAIT_V(8); PG8_WAIT_L(0); PG8_BAR; PG8_MMA(0, 0, At, B0); PG8_MMA(0, 1, At, B1); PG8_BAR; PG8_SCHED;
            PG8_LDA(At, 1, 1); PG8_STAGE(PG8_SB(1, 0), b3, voffB); PG8_STAGE(PG8_SB(1, 1), b3 + hstep, voffB); PG8_STAGE(PG8_SA(1, 0), a3, o2[0]);
            PG8_WAIT_V(8); PG8_WAIT_L(0); PG8_BAR; if (fullu) { PG8_MMA(1, 0, At, B0); PG8_MMA(1, 1, At, B1); } PG8_BAR; PG8_SCHED;
        }
        if constexpr (ALIGN_EPI) { if (wr == 0) PG8_BAR; }
        E(acc, cur, wr, wc, fr, fq, lds, ui);
        if (!has_next) break;
#pragma unroll
        for (int a = 0; a < 2; ++a)
#pragma unroll
            for (int b = 0; b < 2; ++b)
#pragma unroll
                for (int m = 0; m < 4; ++m)
#pragma unroll
                    for (int n = 0; n < 2; ++n) { acc[a][b][m][n] = (f32x4){0.f, 0.f, 0.f, 0.f}; asm volatile("" : "+v"(acc[a][b][m][n])); }
        cur = nxt; cA = nA; cB = nB; ++ui;
#pragma unroll
        for (int h = 0; h < 2; ++h)
#pragma unroll
            for (int i = 0; i < 2; ++i) co[h][i] = no[h][i];
        if constexpr (ALIGN_EPI) { if (wr == 1) PG8_BAR; }
    }
    PG8_WAIT_V(0);
    if constexpr (!ALIGN_EPI) { if (wr == 0) PG8_BAR; }
    PG8_BAR;
#undef PG8_SA
#undef PG8_SB
#undef PG8_STAGE
#undef PG8_LDA
#undef PG8_LDB
#undef PG8_MMA
#undef PG8_WAIT_V
#undef PG8_WAIT_L
#undef PG8_BAR
#undef PG8_SCHED
}

struct EpiBf16 {
    static constexpr bool PERM = true;
    static constexpr bool ADJ = true;
    __device__ __forceinline__ void prefetch(LAS unsigned char*, const Unit&, int, int, int) const {}
    bf16* O; int ldc; float inv;
    __device__ __forceinline__ void operator()(const f32x4 (&acc)[2][2][4][2], const Unit& u, int wr, int wc, int fr, int fq, LAS unsigned char* lds, int ui) const {
        const int row0 = u.pm * BM + wr * 64 + fr, col0 = u.pn * BM + wc * 64 + 8 * fq;
#pragma unroll
        for (int ai = 0; ai < 2; ++ai)
#pragma unroll
            for (int m = 0; m < 4; ++m) { bf16* rowp = O + (size_t)(row0 + ai * HALF + m * 16) * ldc + col0;
#pragma unroll
                for (int bj = 0; bj < 2; ++bj) { const f32x4 v0 = acc[ai][bj][m][0] * inv, v1 = acc[ai][bj][m][1] * inv;
                    u32x4 w; w.x = cvt_pk_bf16(v0[0], v0[1]); w.y = cvt_pk_bf16(v0[2], v0[3]); w.z = cvt_pk_bf16(v1[0], v1[1]); w.w = cvt_pk_bf16(v1[2], v1[3]);
                    *(u32x4*)(rowp + bj * 32) = w; } }
    }
};
template <bool QKF8> struct EpiU {
    static constexpr bool PERM = true;
    static constexpr bool ADJ = true;
    __device__ __forceinline__ void prefetch(LAS unsigned char*, const Unit&, int, int, int) const {}
    bf16* O; const float* rope; float inv;
    __device__ __forceinline__ void operator()(const f32x4 (&acc)[2][2][4][2], const Unit& u, int wr, int wc, int fr, int fq, LAS unsigned char* lds, int ui) const {
        const int row0 = u.pm * BM + wr * 64 + fr, col0 = u.pn * BM + wc * 64 + 8 * fq;
        const bool rot = (u.pn >= 4 && u.pn < 12) && !(u.pm == 0 || u.pm == 17);
        const int axis = wc & 1; const int tb = u.pm >= 17 ? 1 : 0; const int t0 = (u.pm - 1 - 17 * tb) * BM;
#pragma unroll
        for (int bj = 0; bj < 2; ++bj)
#pragma unroll
        for (int mh = 0; mh < 2; ++mh) {
            f32x4 tc[2][2];
            if (rot) { const int c = col0 + bj * 32; const int f0 = (c & 63) >> 1;
#pragma unroll
                for (int k = 0; k < 2; ++k) { const int pos = axis ? (fr + 16 * (2 * mh + k)) : ((t0 >> 6) + wr + 2 * k);
                    const f32x4* cs = (const f32x4*)(rope + ((size_t)pos * 32 + f0) * 2); tc[k][0] = cs[0]; tc[k][1] = cs[1]; } }
#pragma unroll
            for (int ai = 0; ai < 2; ++ai)
#pragma unroll
                for (int mm = 0; mm < 2; ++mm) { const int m = 2 * mh + mm; const int row = row0 + ai * HALF + m * 16; bf16* rowp = O + (size_t)row * NREST + col0;
                    f32x4 v0 = acc[ai][bj][m][0] * inv, v1 = acc[ai][bj][m][1] * inv;
                    if (rot) { f32x4 c01, c23;
#pragma unroll
                        for (int q = 0; q < 4; ++q) { c01[q] = axis ? tc[mm][0][q] : tc[ai][0][q]; c23[q] = axis ? tc[mm][1][q] : tc[ai][1][q]; }
                        f32x4 r0, r1;
                        r0[0] = v0[0] * c01[0] - v0[1] * c01[1]; r0[1] = v0[1] * c01[0] + v0[0] * c01[1];
                        r0[2] = v0[2] * c01[2] - v0[3] * c01[3]; r0[3] = v0[3] * c01[2] + v0[2] * c01[3];
                        r1[0] = v1[0] * c23[0] - v1[1] * c23[1]; r1[1] = v1[1] * c23[0] + v1[0] * c23[1];
                        r1[2] = v1[2] * c23[2] - v1[3] * c23[3]; r1[3] = v1[3] * c23[2] + v1[2] * c23[3];
                        v0 = r0; v1 = r1; }
                    if (QKF8 && ATT_PV8 && u.pn >= 12) {
                        unsigned char* VT = wsb() + WS_VT8; const int tb_ = row >= RB ? 1 : 0, key = row - tb_ * RB, kin = key & 63;
                        const int pos = (key & ~63) + 32 * ((kin >> 2) & 1) + (((kin >> 5) << 4) | (((kin >> 3) & 3) << 2) | (kin & 3));
                        const int dg = col0 - 3072 + bj * 32;
                        unsigned char* vp = VT + ((size_t)(tb_ * 4 + (dg >> 8)) * 256 + (dg & 255)) * RB + pos;
                        int w0 = 0, w1 = 0; w0 = cvt2_fp8(v0[0], v0[1], w0, false); w0 = cvt2_fp8(v0[2], v0[3], w0, true); w1 = cvt2_fp8(v1[0], v1[1], w1, false); w1 = cvt2_fp8(v1[2], v1[3], w1, true);
#pragma unroll
                        for (int e = 0; e < 4; ++e) { vp[(size_t)e * RB] = (unsigned char)((unsigned)w0 >> (8 * e)); vp[(size_t)(4 + e) * RB] = (unsigned char)((unsigned)w1 >> (8 * e)); }
                    } else
                    if (QKF8 && u.pn >= 4 && u.pn < 12) { unsigned char* QK8 = wsb() + WS_QK8;
                        int w0 = 0, w1 = 0; w0 = cvt2_fp8(v0[0], v0[1], w0, false); w0 = cvt2_fp8(v0[2], v0[3], w0, true); w1 = cvt2_fp8(v1[0], v1[1], w1, false); w1 = cvt2_fp8(v1[2], v1[3], w1, true);
                        *(u32x2*)(QK8 + (size_t)row * DM + (col0 - 1024) + bj * 32) = (u32x2){(unsigned)w0, (unsigned)w1};
                    } else {
                    u32x4 w; w.x = cvt_pk_bf16(v0[0], v0[1]); w.y = cvt_pk_bf16(v0[2], v0[3]); w.z = cvt_pk_bf16(v1[0], v1[1]); w.w = cvt_pk_bf16(v1[2], v1[3]);
                    *(u32x4*)(rowp + bj * 32) = w; } } }
    }
};
__device__ __forceinline__ f32x4 bf_lo4(unsigned a, unsigned b) { return (f32x4){__uint_as_float(a << 16), __uint_as_float(a & 0xffff0000u), __uint_as_float(b << 16), __uint_as_float(b & 0xffff0000u)}; }
struct EpiOut {
    static constexpr bool PERM = true;
    static constexpr bool ADJ = true;
    __device__ __forceinline__ void prefetch(LAS unsigned char*, const Unit&, int, int, int) const {}
    int l; float inv;
    __device__ __forceinline__ void operator()(const f32x4 (&acc)[2][2][4][2], const Unit& u, int wr, int wc, int fr, int fq, LAS unsigned char* lds, int ui) const {
        const int row0 = u.pm * BM + wr * 64 + fr, col0 = u.pn * BM + wc * 64 + 8 * fq;
        bf16* R = (bf16*)(wsb() + WS_RBUF);
        const float* gr = (const float*)(wsb() + WS_MOD) + (size_t)l * 3 * (6 * DM) + 2 * DM + (size_t)row_mod(u.pm * BM) * (6 * DM) + col0;
        const int tb = u.pm >= 17 ? 1 : 0, tp = (u.pm - 17 * tb) * BM;
        f32x4 gv[2][2];
#pragma unroll
        for (int bj = 0; bj < 2; ++bj)
#pragma unroll
            for (int n = 0; n < 2; ++n) gv[bj][n] = *(const f32x4*)(gr + bj * 32 + n * 4);
#pragma unroll
        for (int ai = 0; ai < 2; ++ai) {
            f32x4 xv[4][2][2];
            if (l) { const bf16* xb = (const bf16*)(wsb() + WS_XB) + (size_t)u.pm * BM * DM;
#pragma unroll
                for (int m = 0; m < 4; ++m)
#pragma unroll
                    for (int bj = 0; bj < 2; ++bj) xv[m][bj][0] = __builtin_bit_cast(f32x4, __builtin_nontemporal_load((const u32x4*)(xb + (unsigned)((wr * 64 + fr + ai * HALF + m * 16) * DM + col0) + bj * 32)));
            } else { const float* xt = (tp < CTXL ? inp(I_CTX) + (size_t)tb * CTXL * DM : inp(I_X) + ((size_t)tb * SEQ + (tp - CTXL)) * DM);
#pragma unroll
                for (int m = 0; m < 4; ++m) { const float* xr = xt + (unsigned)((wr * 64 + fr + ai * HALF + m * 16) * DM + col0);
#pragma unroll
                    for (int bj = 0; bj < 2; ++bj)
#pragma unroll
                        for (int n = 0; n < 2; ++n) xv[m][bj][n] = __builtin_nontemporal_load((const f32x4*)(xr + bj * 32 + n * 4)); } }
#pragma unroll
            for (int m = 0; m < 4; ++m) { const int row = row0 + ai * HALF + m * 16; bf16* rowp = R + (size_t)row * DM + col0;
#pragma unroll
                for (int bj = 0; bj < 2; ++bj) { f32x4 x0, x1;
                    if (l) { const u32x4 raw = __builtin_bit_cast(u32x4, xv[m][bj][0]); x0 = bf_lo4(raw.x, raw.y); x1 = bf_lo4(raw.z, raw.w); } else { x0 = xv[m][bj][0]; x1 = xv[m][bj][1]; }
                    const f32x4 v0 = x0 * ALPHA + gv[bj][0] * (acc[ai][bj][m][0] * inv), v1 = x1 * ALPHA + gv[bj][1] * (acc[ai][bj][m][1] * inv);
                    u32x4 w; w.x = cvt_pk_bf16(v0[0], v0[1]); w.y = cvt_pk_bf16(v0[2], v0[3]); w.z = cvt_pk_bf16(v1[0], v1[1]); w.w = cvt_pk_bf16(v1[2], v1[3]);
                    *(u32x4*)(rowp + bj * 32) = w; } } }
    }
};
struct EpiMoe1 {
    static constexpr bool PERM = true;
    static constexpr bool ADJ = false;
    __device__ __forceinline__ void prefetch(LAS unsigned char*, const Unit&, int, int, int) const {}
    unsigned char* ACT; float inv;
    __device__ __forceinline__ void operator()(const f32x4 (&acc)[2][2][4][2], const Unit& u, int wr, int wc, int fr, int fq, LAS unsigned char* lds, int ui) const {
        const int row0 = u.pm * BM + wr * 64 + fr, col0 = u.pn * HALF + wc * 32 + 8 * fq;
#pragma unroll
        for (int ai = 0; ai < 2; ++ai)
#pragma unroll
            for (int m = 0; m < 4; ++m) { unsigned char* rowp = ACT + (size_t)(row0 + ai * HALF + m * 16) * DEXP + col0;
                const f32x4 g0 = acc[ai][0][m][0] * inv, g1 = acc[ai][0][m][1] * inv, u0 = acc[ai][1][m][0] * inv, u1 = acc[ai][1][m][1] * inv;
                float a[8];
#pragma unroll
                for (int j = 0; j < 4; ++j) { a[j] = silu_f(g0[j]) * u0[j]; a[4 + j] = silu_f(g1[j]) * u1[j]; }
                int w0 = 0, w1 = 0;
                w0 = cvt2_fp8(a[0], a[1], w0, false); w0 = cvt2_fp8(a[2], a[3], w0, true);
                w1 = cvt2_fp8(a[4], a[5], w1, false); w1 = cvt2_fp8(a[6], a[7], w1, true);
                *(u32x2*)rowp = (u32x2){(unsigned)w0, (unsigned)w1}; }
    }
};
__device__ __forceinline__ int shared_row(int lr, int latent_only) { return latent_only ? (lr < SEQ ? CTXL + lr : RB + CTXL + (lr - SEQ)) : lr; }
struct EpiMoe2 {
    static constexpr bool PERM = true;
    static constexpr bool ADJ = true;
    static constexpr int LISTOFF = 131072;
    __device__ __forceinline__ void prefetch(LAS unsigned char* lds, const Unit& u, int ui, int wid, int lane) const {
        if (u.e != NEXP) { const int* src = (wid < 4 ? ldst : lw) + (size_t)u.e * LCAP + u.rt * BM + (wid & 3) * 64 + lane;
            __builtin_amdgcn_global_load_lds((const unsigned*)src, (LAS unsigned*)(lds + LISTOFF + (ui & 1) * 2048 + (wid >> 2) * 1024 + (wid & 3) * 256), 4, 0, 0); }
    }
    bf16* YG; const int* ldst; const int* lw; const volatile LAS int* cnt; int latent_only; float inv; int nostore;
    __device__ __forceinline__ void operator()(const f32x4 (&acc)[2][2][4][2], const Unit& u, int wr, int wc, int fr, int fq, LAS unsigned char* lds, int ui) const {
        const int r0 = wr * 64 + fr, col0 = u.pn * BM + wc * 64 + 8 * fq;
        const bool shared = (u.e == NEXP); const int nvalid = shared ? (latent_only ? NB * SEQ : M) : __builtin_amdgcn_readfirstlane(cnt[u.e]);
#pragma unroll
        for (int ai = 0; ai < 2; ++ai) {
            int dst[4]; float w[4];
            if (shared) {
#pragma unroll
                for (int m = 0; m < 4; ++m) { const int lr = u.rt * BM + r0 + ai * HALF + m * 16; dst[m] = shared_row(lr, latent_only) * 9 + 8; w[m] = inv; }
            } else { const LAS int* L = (const LAS int*)(lds + LISTOFF + (ui & 1) * 2048);
#pragma unroll
                for (int m = 0; m < 4; ++m) { const int r = r0 + ai * HALF + m * 16; dst[m] = L[r]; w[m] = __int_as_float(L[256 + r]) * inv; }
            }
            if (nostore == 2) {
#pragma unroll
                for (int m = 0; m < 4; ++m) dst[m] = u.pm * 256 + r0 + ai * HALF + m * 16; }
            if (nostore == 3) {
#pragma unroll
                for (int m = 0; m < 4; ++m) dst[m] = r0 + ai * HALF + m * 16; }
#pragma unroll
            for (int m = 0; m < 4; ++m) { const int lr = u.rt * BM + r0 + ai * HALF + m * 16;
                if ((lr < nvalid && !nostore) || nostore >= 2) {
#if YG_F8
                    unsigned char* rowp8 = (unsigned char*)YG + (size_t)dst[m] * DM + col0; const float ws8 = w[m] * YG8_SCALE;
#pragma unroll
                    for (int bj = 0; bj < 2; ++bj) { const f32x4 v0 = acc[ai][bj][m][0] * ws8, v1 = acc[ai][bj][m][1] * ws8;
                        int w0 = 0, w1 = 0; w0 = cvt2_fp8(v0[0], v0[1], w0, false); w0 = cvt2_fp8(v0[2], v0[3], w0, true); w1 = cvt2_fp8(v1[0], v1[1], w1, false); w1 = cvt2_fp8(v1[2], v1[3], w1, true);
                        *(u32x2*)(rowp8 + bj * 32) = (u32x2){(unsigned)w0, (unsigned)w1}; } } } }
#else
                    bf16* rowp = (nostore == 3 ? (bf16*)(wsb() + WS_U) : YG) + (size_t)dst[m] * DM + col0; const float ws_ = w[m];
#pragma unroll
                    for (int bj = 0; bj < 2; ++bj) { const f32x4 v0 = acc[ai][bj][m][0] * ws_, v1 = acc[ai][bj][m][1] * ws_;
                        u32x4 o; o.x = cvt_pk_bf16(v0[0], v0[1]); o.y = cvt_pk_bf16(v0[2], v0[3]); o.z = cvt_pk_bf16(v1[0], v1[1]); o.w = cvt_pk_bf16(v1[2], v1[3]);
                        *(u32x4*)(rowp + bj * 32) = o; } } } }
#endif
    }
};

template <int RS, int NTN, bool GATHER> struct MoeSched {
    const volatile LAS int* tpre; const volatile LAS int* fpre; int G, c;
    const unsigned char* A; const unsigned char* Bt;
    const int* ltok; const volatile LAS int* cnt; int latent_only;
    const volatile LAS int* ulist = nullptr; int ucap = 0;
    __device__ bool next(int i, Unit& u) const {
#define RFL(v) __builtin_amdgcn_readfirstlane(v)
        if (i < ucap) { const int e = RFL(ulist[4 * i]); if (e < 0) return false; u.e = e; u.rt = RFL(ulist[4 * i + 1]); u.pn = RFL(ulist[4 * i + 2]); u.pm = RFL(ulist[4 * i + 3]); return true; }
        const int L = i * G + c; const int nfull = RFL(fpre[NEX1]), ntail = RFL(fpre[NEX1 + 1]);
        if (L >= (nfull + ntail) * NTN) return false;
        int ti = L / NTN; u.pn = L % NTN; int e;
        if (ti < nfull) { int lo = 0, hi = NEX1;
            while (hi - lo > 1) { const int mid = (lo + hi) >> 1; if (RFL(fpre[mid]) <= ti) lo = mid; else hi = mid; }
            e = lo; u.rt = ti - RFL(fpre[e]); }
        else { e = RFL(fpre[NEX1 + 2 + (ti - nfull)]); u.rt = RFL(tpre[e + 1]) - RFL(tpre[e]) - 1; }
        u.e = e; u.pm = RFL(tpre[e]) + u.rt; return true;
#undef RFL
    }
    __device__ __forceinline__ bool half(const Unit& u) const { const int nvalid = (u.e == NEXP) ? (latent_only ? NB * SEQ : M) : __builtin_amdgcn_readfirstlane(cnt[u.e]); return nvalid - u.rt * 256 <= HALF; }
    __device__ __forceinline__ const char* a_base(const Unit& u) const { return GATHER ? (const char*)A : (const char*)A + (size_t)u.pm * 256 * RS; }
    __device__ __forceinline__ const char* b_base(const Unit& u) const { return (const char*)Bt + ((size_t)u.e * (NTN * 256) + (size_t)u.pn * 256) * RS; }
    __device__ __forceinline__ void a_offs(const Unit& u, unsigned (&o)[2][2], const int (&R)[2], const unsigned (&cb)[2]) const {
        if constexpr (GATHER) {
            const bool shared = (u.e == NEXP); const int nvalid = shared ? (latent_only ? NB * SEQ : M) : __builtin_amdgcn_readfirstlane(cnt[u.e]);
            int tok[2][2];
            if (shared) {
#pragma unroll
                for (int h = 0; h < 2; ++h)
#pragma unroll
                    for (int i = 0; i < 2; ++i) { const int lr = u.rt * 256 + h * HALF + R[i]; tok[h][i] = shared_row(lr < nvalid ? lr : 0, latent_only); }
            } else {
                const int* lp = ltok + (size_t)u.e * LCAP;
#pragma unroll
                for (int h = 0; h < 2; ++h)
#pragma unroll
                    for (int i = 0; i < 2; ++i) { const int lr = u.rt * 256 + h * HALF + R[i]; tok[h][i] = lp[lr < nvalid ? lr : 0]; }
#pragma unroll
                for (int h = 0; h < 2; ++h)
#pragma unroll
                    for (int i = 0; i < 2; ++i) { const int lr = u.rt * 256 + h * HALF + R[i]; tok[h][i] = lr < nvalid ? tok[h][i] : CTXL; }
            }
#pragma unroll
            for (int h = 0; h < 2; ++h)
#pragma unroll
                for (int i = 0; i < 2; ++i) o[h][i] = (unsigned)tok[h][i] * (unsigned)RS + cb[i];
        } else {
#pragma unroll
            for (int h = 0; h < 2; ++h)
#pragma unroll
                for (int i = 0; i < 2; ++i) o[h][i] = (unsigned)((h * HALF + R[i]) * RS) + cb[i];
        }
    }
};
}

namespace att {
constexpr int D = 128, NW = 8, QBLK = 32, KVBLK = 64;
constexpr float SCALE = 0.088388347648318440f;
constexpr float THR = 8.f;
constexpr int SDEPTH = 2;
constexpr size_t SHM_V = KVBLK * D * 2, SHM_K = KVBLK * D * 2, SHM_ATTN = 2 * SHM_V + 2 * SHM_K + NW * 64 * 4;
#define KSWZ(row, colB) ((row) * 256 + ((colB) ^ (((row) & 7) << 4)))
#define SBAR() __builtin_amdgcn_sched_barrier(0)
__device__ __forceinline__ int crow(int r, int hi) { return (r & 3) + 8 * (r >> 2) + 4 * hi; }
__device__ __forceinline__ unsigned cvtpk(float lo, float hi) { unsigned r; asm volatile("v_cvt_pk_bf16_f32 %0, %1, %2" : "=v"(r) : "v"(lo), "v"(hi)); return r; }
__device__ __forceinline__ bf16x8 ld8(const bf16* p) { return *reinterpret_cast<const bf16x8*>(p); }

__device__ __forceinline__ void partialSM(f32x16& p0, f32x16& p1, float& m_reg, float& mn, float& alpha) {
  constexpr float C = SCALE * 1.4426950408889634f;
  float pmax = p0[0]; for (int r = 1; r < 16; ++r) pmax = fmaxf(pmax, p0[r]); for (int r = 0; r < 16; ++r) pmax = fmaxf(pmax, p1[r]);
  { auto rr = __builtin_amdgcn_permlane32_swap(__float_as_uint(pmax), __float_as_uint(pmax), false, false);
    pmax = fmaxf(__uint_as_float(rr[0]), __uint_as_float(rr[1])); }
  if (__builtin_expect(__all(pmax - m_reg <= THR / SCALE), 1)) { mn = m_reg; alpha = 1.f; }
  else { mn = fmaxf(m_reg, pmax); alpha = __builtin_amdgcn_exp2f((m_reg - mn) * C); m_reg = mn; }
  float mnC = -mn * C;
  for (int r = 0; r < 16; ++r) p0[r] = fmaf(p0[r], C, mnC); for (int r = 0; r < 16; ++r) p1[r] = fmaf(p1[r], C, mnC);
  for (int r = 0; r < 16; ++r) p0[r] = __builtin_amdgcn_exp2f(p0[r]);
}
__device__ __forceinline__ void finishSM(f32x16& p0, f32x16& p1, float alpha, float& l_reg, bf16x8& pa0, bf16x8& pa1, bf16x8& pa2, bf16x8& pa3) {
  for (int r = 0; r < 16; ++r) p1[r] = __builtin_amdgcn_exp2f(p1[r]);
  float ps = 0; for (int r = 0; r < 16; ++r) ps += p0[r]; for (int r = 0; r < 16; ++r) ps += p1[r];
  { auto rr = __builtin_amdgcn_permlane32_swap(__float_as_uint(ps), __float_as_uint(ps), false, false);
    ps = __uint_as_float(rr[0]) + __uint_as_float(rr[1]); }
  l_reg = l_reg * alpha + ps;
#define PK4(P, BASE, OUT) do { unsigned a0 = cvtpk(P[BASE + 0], P[BASE + 1]), a1 = cvtpk(P[BASE + 2], P[BASE + 3]);   \
    unsigned b0 = cvtpk(P[BASE + 4], P[BASE + 5]), b1 = cvtpk(P[BASE + 6], P[BASE + 7]);                              \
    auto r0 = __builtin_amdgcn_permlane32_swap(a0, b0, false, false); auto r1 = __builtin_amdgcn_permlane32_swap(a1, b1, false, false); \
    u32x4 w = {r0[0], r1[0], r0[1], r1[1]}; OUT = *reinterpret_cast<bf16x8*>(&w); } while (0)
  PK4(p0, 0, pa0); PK4(p0, 8, pa1); PK4(p1, 0, pa2); PK4(p1, 8, pa3);
#undef PK4
}
__device__ __forceinline__ void qkt(f32x16& p0, f32x16& p1, const bf16* Ks, const bf16x8* qr, int r32, int hi) {
  p0 = f32x16{}; p1 = f32x16{};
  for (int d0 = 0; d0 < 8; ++d0) { int cb = (d0 * 16 + hi * 8) * 2;
    bf16x8 b0 = *reinterpret_cast<const bf16x8*>((const char*)Ks + KSWZ(r32, cb));
    bf16x8 b1 = *reinterpret_cast<const bf16x8*>((const char*)Ks + KSWZ(32 + r32, cb));
    p0 = __builtin_amdgcn_mfma_f32_32x32x16_bf16(b0, qr[d0], p0, 0, 0, 0);
    p1 = __builtin_amdgcn_mfma_f32_32x32x16_bf16(b1, qr[d0], p1, 0, 0, 0); }
}
__device__ __forceinline__ int v_st(int k, int c) { const int kk = (k & ~0xC) | ((k & 4) << 1) | ((k & 8) >> 1); return ((kk >> 3) * 4 + (c >> 5)) * 512 + ((kk & 7) * 32 + (c & 31)) * 2; }
__device__ __forceinline__ int v_rd_base(int lane) { return ((lane & 3) << 3) | (((lane >> 2) & 3) << 6) | (((lane >> 4) & 1) << 5) | (((lane >> 5) & 1) << 8); }
constexpr int v_rd_off(int d0, int ks, int half) { return d0 * 512 + ks * 4096 + half * 2048; }
template <int OFF> __device__ __forceinline__ s16x4 tr_read(int vb) {
  s16x4 r; asm volatile("ds_read_b64_tr_b16 %0, %1 offset:%2" : "=&v"(r) : "v"(vb), "i"(OFF) : "memory"); return r;
}
template <int D0> __device__ __forceinline__ void pv_one(f32x16& od, int vb, bf16x8 pa0, bf16x8 pa1, bf16x8 pa2, bf16x8 pa3) {
  const s16x4 l0 = tr_read<v_rd_off(D0, 0, 0)>(vb), h0 = tr_read<v_rd_off(D0, 0, 1)>(vb), l1 = tr_read<v_rd_off(D0, 1, 0)>(vb), h1 = tr_read<v_rd_off(D0, 1, 1)>(vb);
  const s16x4 l2 = tr_read<v_rd_off(D0, 2, 0)>(vb), h2 = tr_read<v_rd_off(D0, 2, 1)>(vb), l3 = tr_read<v_rd_off(D0, 3, 0)>(vb), h3 = tr_read<v_rd_off(D0, 3, 1)>(vb);
  asm volatile("s_waitcnt lgkmcnt(0)" ::: "memory"); SBAR();
#define PK(L, H) (bf16x8){L[0], L[1], L[2], L[3], H[0], H[1], H[2], H[3]}
  od = __builtin_amdgcn_mfma_f32_32x32x16_bf16(pa0, PK(l0, h0), od, 0, 0, 0);
  od = __builtin_amdgcn_mfma_f32_32x32x16_bf16(pa1, PK(l1, h1), od, 0, 0, 0);
  od = __builtin_amdgcn_mfma_f32_32x32x16_bf16(pa2, PK(l2, h2), od, 0, 0, 0);
  od = __builtin_amdgcn_mfma_f32_32x32x16_bf16(pa3, PK(l3, h3), od, 0, 0, 0);
#undef PK
}
__device__ __forceinline__ void pv_d0(f32x16* o, int vb, bf16x8 pa0, bf16x8 pa1, bf16x8 pa2, bf16x8 pa3) {
  pv_one<0>(o[0], vb, pa0, pa1, pa2, pa3); pv_one<1>(o[1], vb, pa0, pa1, pa2, pa3); pv_one<2>(o[2], vb, pa0, pa1, pa2, pa3); pv_one<3>(o[3], vb, pa0, pa1, pa2, pa3);
}
template <int LDQ, int LDK, int LDO>
__device__ __forceinline__ void attn_dense_body(const bf16* __restrict__ Qb, const bf16* __restrict__ Kh, const bf16* __restrict__ Vh, float* __restrict__ Ob, int seq, char* lds, int wid) {
  int lane_ = lane_now(); asm volatile("" : "+v"(lane_));
  const int lane = lane_, tid = wid * 64 + lane, r32 = lane & 31, hi = lane >> 5;
  bf16* V_lds = (bf16*)lds; bf16* K_lds = (bf16*)(lds + 2 * SHM_V);
  float* ws = (float*)(lds + 2 * SHM_V + 2 * SHM_K) + wid * 64; float* li_l = ws; float* al_l = ws + 32;
  float m_reg = -1e30f, l_reg = 0; f32x16 o[4] = {}; bf16x8 qr[8];
  const bf16* Qw = Qb + (long)(wid * QBLK + r32) * LDQ + hi * 8;
#pragma unroll
  for (int d0 = 0; d0 < 8; ++d0) qr[d0] = ld8(Qw + d0 * 16);
  const int sr = tid >> 4, sc = (tid & 15) * 8, vst0 = v_st(sr, sc), vst1 = v_st(32 + sr, sc);
  const int vb0 = (int)(uintptr_t)V_lds + v_rd_base(lane);
  struct { bf16x8 vs0, vs1, ks0, ks1; } sr_[SDEPTH];
#define SLOAD(i, k0) do { sr_[i].vs0 = ld8(&Vh[(long)((k0) + sr) * LDK + sc]); sr_[i].vs1 = ld8(&Vh[(long)((k0) + 32 + sr) * LDK + sc]); \
    sr_[i].ks0 = ld8(&Kh[(long)((k0) + sr) * LDK + sc]); sr_[i].ks1 = ld8(&Kh[(long)((k0) + 32 + sr) * LDK + sc]); } while (0)
#define SWRITE(b, i) do { *(bf16x8*)((char*)V_lds + (b) * SHM_V + vst0) = sr_[i].vs0;          \
    *(bf16x8*)((char*)V_lds + (b) * SHM_V + vst1) = sr_[i].vs1; int kc = sc * 2;               \
    *(bf16x8*)((char*)K_lds + (b) * SHM_K + KSWZ(sr, kc)) = sr_[i].ks0;                       \
    *(bf16x8*)((char*)K_lds + (b) * SHM_K + KSWZ(32 + sr, kc)) = sr_[i].ks1; } while (0)
#define SWAIT() do { asm volatile("s_waitcnt vmcnt(4)" ::: "memory"); } while (0)
#define RESC(a) do { if (__any((a) < 1.f)) { if (hi == 0) al_l[r32] = (a); asm volatile("s_waitcnt lgkmcnt(0)" ::: "memory"); \
    for (int d = 0; d < 4; ++d) for (int r = 0; r < 16; ++r) o[d][r] *= al_l[crow(r, hi)]; } } while (0)
  f32x16 pA0, pA1, pB0, pB1; float mnA, mnB, alA, alB; bf16x8 pa0, pa1, pa2, pa3; const int NT = seq / KVBLK;
  constexpr int SE = 0, SO = SDEPTH - 1;
  SLOAD(SE, 0); asm volatile("s_waitcnt vmcnt(0)" ::: "memory"); SWRITE(0, SE); __syncthreads();
  qkt(pA0, pA1, K_lds, qr, r32, hi); partialSM(pA0, pA1, m_reg, mnA, alA);
  SLOAD(SO, KVBLK); if (2 < NT) SLOAD(SE, 2 * KVBLK);
  SWAIT(); SWRITE(1, SO); __syncthreads();
  for (int j = 1; j + 1 < NT; j += 2) {
    SBAR(); qkt(pB0, pB1, (bf16*)((char*)K_lds + SHM_K), qr, r32, hi);
    finishSM(pA0, pA1, alA, l_reg, pa0, pa1, pa2, pa3); SBAR();
    SLOAD(SO, (j + SDEPTH) * KVBLK); SBAR();
    pv_d0(o, vb0, pa0, pa1, pa2, pa3); partialSM(pB0, pB1, m_reg, mnB, alB);
    __syncthreads(); SWAIT(); SWRITE(0, SE);
    RESC(alB); __syncthreads();
    SBAR(); qkt(pA0, pA1, K_lds, qr, r32, hi);
    finishSM(pB0, pB1, alB, l_reg, pa0, pa1, pa2, pa3); SBAR();
    if (j + 3 < NT) SLOAD(SE, (j + 1 + SDEPTH) * KVBLK); SBAR();
    pv_d0(o, vb0 + (int)SHM_V, pa0, pa1, pa2, pa3); partialSM(pA0, pA1, m_reg, mnA, alA);
    __syncthreads(); SWAIT(); SWRITE(1, SO);
    RESC(alA); __syncthreads();
  }
  SBAR(); qkt(pB0, pB1, (bf16*)((char*)K_lds + SHM_K), qr, r32, hi);
  finishSM(pA0, pA1, alA, l_reg, pa0, pa1, pa2, pa3); SBAR();
  pv_d0(o, vb0, pa0, pa1, pa2, pa3); partialSM(pB0, pB1, m_reg, mnB, alB);
  __syncthreads(); RESC(alB);
  finishSM(pB0, pB1, alB, l_reg, pa0, pa1, pa2, pa3); SBAR();
  pv_d0(o, vb0 + (int)SHM_V, pa0, pa1, pa2, pa3);
  if (hi == 0) li_l[r32] = l_reg; asm volatile("s_waitcnt lgkmcnt(0)" ::: "memory");
  float rli[16];
#pragma unroll
  for (int r = 0; r < 16; ++r) rli[r] = __builtin_amdgcn_rcpf(li_l[crow(r, hi)]);
  float* Ow = Ob + (long)(wid * QBLK) * LDO;
#pragma unroll
  for (int r = 0; r < 16; ++r) { int orow = crow(r, hi);
    for (int d0 = 0; d0 < 4; ++d0) Ow[(long)orow * LDO + d0 * 32 + r32] = o[d0][r] * rli[r]; }
  __syncthreads();
#undef SLOAD
#undef SWRITE
#undef SWAIT
#undef RESC
}
constexpr size_t SHM_K8 = KVBLK * D;
#define KSWZ8(row, colB) ((row) * 128 + ((colB) ^ ((((row) >> 1) & 7) << 4)))
typedef int i32x8 __attribute__((ext_vector_type(8)));
__device__ __forceinline__ i32x8 cat8i(u32x4 a, u32x4 b) { return (i32x8){(int)a.x, (int)a.y, (int)a.z, (int)a.w, (int)b.x, (int)b.y, (int)b.z, (int)b.w}; }
__device__ __forceinline__ void qkt8_qlds(f32x16& p0, f32x16& p1, const char* Ks, const char* Qs, int r32, int hi) {
  p0 = f32x16{}; p1 = f32x16{};
#pragma unroll
  for (int ks = 0; ks < 2; ++ks) { const int c0 = 64 * ks + 32 * hi;
    const i32x8 qf = cat8i(*(const u32x4*)(Qs + ks * 2048), *(const u32x4*)(Qs + ks * 2048 + 16));
    const i32x8 a0 = cat8i(*(const u32x4*)(Ks + KSWZ8(r32, c0)), *(const u32x4*)(Ks + KSWZ8(r32, c0 + 16)));
    const i32x8 a1 = cat8i(*(const u32x4*)(Ks + KSWZ8(32 + r32, c0)), *(const u32x4*)(Ks + KSWZ8(32 + r32, c0 + 16)));
    p0 = __builtin_amdgcn_mfma_scale_f32_32x32x64_f8f6f4(a0, qf, p0, 0, 0, 0, 0, 0, 0);
    p1 = __builtin_amdgcn_mfma_scale_f32_32x32x64_f8f6f4(a1, qf, p1, 0, 0, 0, 0, 0, 0); }
}
__device__ __forceinline__ void qkt8(f32x16& p0, f32x16& p1, const char* Ks, const i32x8* qr, int r32, int hi) {
  p0 = f32x16{}; p1 = f32x16{};
#pragma unroll
  for (int ks = 0; ks < 2; ++ks) { const int c0 = 64 * ks + 32 * hi;
    const i32x8 a0 = cat8i(*(const u32x4*)(Ks + KSWZ8(r32, c0)), *(const u32x4*)(Ks + KSWZ8(r32, c0 + 16)));
    const i32x8 a1 = cat8i(*(const u32x4*)(Ks + KSWZ8(32 + r32, c0)), *(const u32x4*)(Ks + KSWZ8(32 + r32, c0 + 16)));
    p0 = __builtin_amdgcn_mfma_scale_f32_32x32x64_f8f6f4(a0, qr[ks], p0, 0, 0, 0, 0, 0, 0);
    p1 = __builtin_amdgcn_mfma_scale_f32_32x32x64_f8f6f4(a1, qr[ks], p1, 0, 0, 0, 0, 0, 0); }
}
template <int LDQ8, int LDK8, int LDK, int LDO>
__device__ __forceinline__ void attn_dense_body_qk8(const unsigned char* __restrict__ Qb, const unsigned char* __restrict__ Kh, const bf16* __restrict__ Vh, float* __restrict__ Ob, int seq, char* lds, int wid) {
  int lane_ = lane_now(); asm volatile("" : "+v"(lane_));
  const int lane = lane_, tid = wid * 64 + lane, r32 = lane & 31, hi = lane >> 5;
  bf16* V_lds = (bf16*)lds; char* K_lds = lds + 2 * SHM_V;
  float* ws = (float*)(lds + 2 * SHM_V + 2 * SHM_K8) + wid * 64; float* li_l = ws; float* al_l = ws + 32;
  float m_reg = -1e30f, l_reg = 0; f32x16 o[4] = {}; i32x8 qr[2];
  const unsigned char* Qw = Qb + (long)(wid * QBLK + r32) * LDQ8 + hi * 32;
#pragma unroll
  for (int ks = 0; ks < 2; ++ks) qr[ks] = cat8i(*(const u32x4*)(Qw + 64 * ks), *(const u32x4*)(Qw + 64 * ks + 16));
  const int sr = tid >> 4, sc = (tid & 15) * 8, vst0 = v_st(sr, sc), vst1 = v_st(32 + sr, sc);
  const int vb0 = (int)(uintptr_t)V_lds + v_rd_base(lane);
  const int kr = tid >> 3, kc = (tid & 7) * 16;
  struct { bf16x8 vs0, vs1; u32x4 ks0; } sr_[SDEPTH];
#define SLOAD(i, k0) do { sr_[i].vs0 = ld8(&Vh[(long)((k0) + sr) * LDK + sc]); sr_[i].vs1 = ld8(&Vh[(long)((k0) + 32 + sr) * LDK + sc]); \
    sr_[i].ks0 = *(const u32x4*)(Kh + (long)((k0) + kr) * LDK8 + kc); } while (0)
#define SWRITE(b, i) do { *(bf16x8*)((char*)V_lds + (b) * SHM_V + vst0) = sr_[i].vs0;          \
    *(bf16x8*)((char*)V_lds + (b) * SHM_V + vst1) = sr_[i].vs1;                                \
    *(u32x4*)(K_lds + (b) * SHM_K8 + KSWZ8(kr, kc)) = sr_[i].ks0; } while (0)
#define SWAIT() do { asm volatile("s_waitcnt vmcnt(3)" ::: "memory"); } while (0)
#define RESC(a) do { if (__any((a) < 1.f)) { if (hi == 0) al_l[r32] = (a); asm volatile("s_waitcnt lgkmcnt(0)" ::: "memory"); \
    for (int d = 0; d < 4; ++d) for (int r = 0; r < 16; ++r) o[d][r] *= al_l[crow(r, hi)]; } } while (0)
  f32x16 pA0, pA1, pB0, pB1; float mnA, mnB, alA, alB; bf16x8 pa0, pa1, pa2, pa3; const int NT = seq / KVBLK;
  constexpr int SE = 0, SO = SDEPTH - 1;
  SLOAD(SE, 0); asm volatile("s_waitcnt vmcnt(0)" ::: "memory"); SWRITE(0, SE); __syncthreads();
  qkt8(pA0, pA1, K_lds, qr, r32, hi); partialSM(pA0, pA1, m_reg, mnA, alA);
  SLOAD(SO, KVBLK); if (2 < NT) SLOAD(SE, 2 * KVBLK);
  SWAIT(); SWRITE(1, SO); __syncthreads();
  for (int j = 1; j + 1 < NT; j += 2) {
    SBAR(); qkt8(pB0, pB1, K_lds + SHM_K8, qr, r32, hi);
    finishSM(pA0, pA1, alA, l_reg, pa0, pa1, pa2, pa3); SBAR();
    SLOAD(SO, (j + SDEPTH) * KVBLK); SBAR();
    pv_d0(o, vb0, pa0, pa1, pa2, pa3); partialSM(pB0, pB1, m_reg, mnB, alB);
    __syncthreads(); SWAIT(); SWRITE(0, SE);
    RESC(alB); __syncthreads();
    SBAR(); qkt8(pA0, pA1, K_lds, qr, r32, hi);
    finishSM(pB0, pB1, alB, l_reg, pa0, pa1, pa2, pa3); SBAR();
    if (j + 3 < NT) SLOAD(SE, (j + 1 + SDEPTH) * KVBLK); SBAR();
    pv_d0(o, vb0 + (int)SHM_V, pa0, pa1, pa2, pa3); partialSM(pA0, pA1, m_reg, mnA, alA);
    __syncthreads(); SWAIT(); SWRITE(1, SO);
    RESC(alA); __syncthreads();
  }
  SBAR(); qkt8(pB0, pB1, K_lds + SHM_K8, qr, r32, hi);
  finishSM(pA0, pA1, alA, l_reg, pa0, pa1, pa2, pa3); SBAR();
  pv_d0(o, vb0, pa0, pa1, pa2, pa3); partialSM(pB0, pB1, m_reg, mnB, alB);
  __syncthreads(); RESC(alB);
  finishSM(pB0, pB1, alB, l_reg, pa0, pa1, pa2, pa3); SBAR();
  pv_d0(o, vb0 + (int)SHM_V, pa0, pa1, pa2, pa3);
  if (hi == 0) li_l[r32] = l_reg; asm volatile("s_waitcnt lgkmcnt(0)" ::: "memory");
  float rli[16];
#pragma unroll
  for (int r = 0; r < 16; ++r) rli[r] = __builtin_amdgcn_rcpf(li_l[crow(r, hi)]);
  float* Ow = Ob + (long)(wid * QBLK) * LDO;
#pragma unroll
  for (int r = 0; r < 16; ++r) { int orow = crow(r, hi);
    for (int d0 = 0; d0 < 4; ++d0) Ow[(long)orow * LDO + d0 * 32 + r32] = o[d0][r] * rli[r]; }
  __syncthreads();
#undef SLOAD
#undef SWRITE
#undef SWAIT
#undef RESC
}
constexpr size_t SHM_V8 = D * KVBLK;
constexpr float THR8 = 2.6f, PSH8 = 5.0f;
#define VSWZ8(row, colB) ((row) * 64 + ((colB) ^ ((((row) >> 2) & 3) << 4)))
__device__ __forceinline__ float fexp_bits(float t) { unsigned u; asm("v_cvt_u32_f32 %0, %1" : "=v"(u) : "v"(t)); return __uint_as_float(u); }
__device__ __forceinline__ void partialSM8(f32x16& p0, f32x16& p1, float& m_reg, float& mn, float& alpha) {
  constexpr float C = SCALE * 1.4426950408889634f;
  float pmax = p0[0]; for (int r = 1; r < 16; ++r) pmax = fmaxf(pmax, p0[r]); for (int r = 0; r < 16; ++r) pmax = fmaxf(pmax, p1[r]);
  { auto rr = __builtin_amdgcn_permlane32_swap(__float_as_uint(pmax), __float_as_uint(pmax), false, false);
    pmax = fmaxf(__uint_as_float(rr[0]), __uint_as_float(rr[1])); }
  if (__builtin_expect(__all(pmax - m_reg <= THR8 / SCALE), 1)) { mn = m_reg; alpha = 1.f; }
  else { mn = fmaxf(m_reg, pmax); alpha = __builtin_amdgcn_exp2f((m_reg - mn) * C); m_reg = mn; }
#if ATT_FASTEXP
  const float C23 = C * 8388608.0f, b23 = (-mn * C + PSH8 + 127.0f) * 8388608.0f;
  for (int r = 0; r < 16; ++r) p0[r] = fmaf(p0[r], C23, b23); for (int r = 0; r < 16; ++r) p1[r] = fmaf(p1[r], C23, b23);
  for (int r = 0; r < 16; ++r) p0[r] = fexp_bits(p0[r]);
#else
  float mnC = -mn * C + PSH8;
  for (int r = 0; r < 16; ++r) p0[r] = fmaf(p0[r], C, mnC); for (int r = 0; r < 16; ++r) p1[r] = fmaf(p1[r], C, mnC);
  for (int r = 0; r < 16; ++r) p0[r] = __builtin_amdgcn_exp2f(p0[r]);
#endif
}
__device__ __forceinline__ void finishSM8(f32x16& p0, f32x16& p1, float alpha, float& l_reg, i32x8& pa) {
#if ATT_FASTEXP
  for (int r = 0; r < 16; ++r) p1[r] = fexp_bits(p1[r]);
#else
  for (int r = 0; r < 16; ++r) p1[r] = __builtin_amdgcn_exp2f(p1[r]);
#endif
  float ps = 0; for (int r = 0; r < 16; ++r) ps += p0[r]; for (int r = 0; r < 16; ++r) ps += p1[r];
  { auto rr = __builtin_amdgcn_permlane32_swap(__float_as_uint(ps), __float_as_uint(ps), false, false);
    ps = __uint_as_float(rr[0]) + __uint_as_float(rr[1]); }
  l_reg = l_reg * alpha + ps;
#pragma unroll
  for (int i = 0; i < 4; ++i) { int w = 0; w = __builtin_amdgcn_cvt_pk_fp8_f32(p0[4 * i], p0[4 * i + 1], w, false); w = __builtin_amdgcn_cvt_pk_fp8_f32(p0[4 * i + 2], p0[4 * i + 3], w, true); pa[i] = w;
    int x = 0; x = __builtin_amdgcn_cvt_pk_fp8_f32(p1[4 * i], p1[4 * i + 1], x, false); x = __builtin_amdgcn_cvt_pk_fp8_f32(p1[4 * i + 2], p1[4 * i + 3], x, true); pa[4 + i] = x; }
}
#define PV8_RD(d0_) cat8i(*(const u32x4*)(Vs + VSWZ8(32 * (d0_) + r32, 32 * hi)), *(const u32x4*)(Vs + VSWZ8(32 * (d0_) + r32, 32 * hi + 16)))
#define PV8_MM(d0_, f_) o[d0_] = __builtin_amdgcn_mfma_scale_f32_32x32x64_f8f6f4(pa, f_, o[d0_], 0, 0, 0, 0, 0, 0)
template <int NV> __device__ __forceinline__ void pv8(f32x16* o, const char* Vs, i32x8 pa, int r32, int hi) {
  i32x8 f0 = PV8_RD(0), f1 = PV8_RD(1), f2 = PV8_RD(2), f3 = PV8_RD(3); SBAR();
  if constexpr (NV == 2) {
    PV8_MM(0, f0); SBAR(); f0 = PV8_RD(4); SBAR();
    PV8_MM(1, f1); SBAR(); f1 = PV8_RD(5); SBAR();
    PV8_MM(2, f2); SBAR(); f2 = PV8_RD(6); SBAR();
    PV8_MM(3, f3); SBAR(); f3 = PV8_RD(7); SBAR();
    PV8_MM(4, f0); SBAR(); PV8_MM(5, f1); SBAR(); PV8_MM(6, f2); SBAR(); PV8_MM(7, f3);
  } else {
    PV8_MM(0, f0); SBAR(); PV8_MM(1, f1); SBAR(); PV8_MM(2, f2); SBAR(); PV8_MM(3, f3);
  }
}
#undef PV8_RD
#undef PV8_MM
template <int NV, int LDQ8, int LDK8, int LDK, int LDO>
__device__ __forceinline__ void attn_dense_body_f8(const unsigned char* __restrict__ Qb, const unsigned char* __restrict__ Kh, const unsigned char* __restrict__ Vh, float* __restrict__ Ob, int seq, char* lds, int wid) {
  int lane_ = lane_now(); asm volatile("" : "+v"(lane_));
  const int lane = lane_, tid = wid * 64 + lane, r32 = lane & 31, hi = lane >> 5;
  constexpr int SHV = NV * (int)SHM_V8;
  char* V_lds = lds; char* K_lds = lds + 2 * SHV;
  float* ws = (float*)(lds + 2 * SHV + 2 * SHM_K8) + wid * 64; float* li_l = ws; float* al_l = ws + 32;
  float m_reg = -1e30f, l_reg = 0; f32x16 o[4 * NV] = {}; i32x8 qr[2];
  const unsigned char* Qw = Qb + (long)(wid * QBLK + r32) * LDQ8 + hi * 32;
#pragma unroll
  for (int ks = 0; ks < 2; ++ks) qr[ks] = cat8i(*(const u32x4*)(Qw + 64 * ks), *(const u32x4*)(Qw + 64 * ks + 16));
  const int vd = tid >> 2, vc = (tid & 3) * 16;
  const int kr = tid >> 3, kc = (tid & 7) * 16;
  struct { u32x4 vs0[NV]; u32x4 ks0; } sr_[SDEPTH];
#define SLOAD(i, k0) do { _Pragma("unroll") for (int v_ = 0; v_ < NV; ++v_) sr_[i].vs0[v_] = *(const u32x4*)(Vh + (long)(vd + 128 * v_) * LDK + (k0) + vc); \
    sr_[i].ks0 = *(const u32x4*)(Kh + (long)((k0) + kr) * LDK8 + kc); } while (0)
#define SWRITE(b, i) do { _Pragma("unroll") for (int v_ = 0; v_ < NV; ++v_) *(u32x4*)(V_lds + (b) * SHV + VSWZ8(vd + 128 * v_, vc)) = sr_[i].vs0[v_];          \
    *(u32x4*)(K_lds + (b) * SHM_K8 + KSWZ8(kr, kc)) = sr_[i].ks0; } while (0)
#define SWAIT() do { if (NV == 1) asm volatile("s_waitcnt vmcnt(2)" ::: "memory"); else asm volatile("s_waitcnt vmcnt(3)" ::: "memory"); } while (0)
#define RESC(a) do { if (__any((a) < 1.f)) { if (hi == 0) al_l[r32] = (a); asm volatile("s_waitcnt lgkmcnt(0)" ::: "memory"); \
    for (int d = 0; d < 4 * NV; ++d) for (int r = 0; r < 16; ++r) o[d][r] *= al_l[crow(r, hi)]; } } while (0)
  f32x16 pA0, pA1, pB0, pB1; float mnA, mnB, alA, alB; i32x8 pa; const int NT = seq / KVBLK;
  constexpr int SE = 0, SO = SDEPTH - 1;
  SLOAD(SE, 0); asm volatile("s_waitcnt vmcnt(0)" ::: "memory"); SWRITE(0, SE); __syncthreads();
  qkt8(pA0, pA1, K_lds, qr, r32, hi); partialSM8(pA0, pA1, m_reg, mnA, alA);
  SLOAD(SO, KVBLK); if (2 < NT) SLOAD(SE, 2 * KVBLK);
  SWAIT(); SWRITE(1, SO); __syncthreads();
  for (int j = 1; j + 1 < NT; j += 2) {
    SBAR(); qkt8(pB0, pB1, K_lds + SHM_K8, qr, r32, hi);
    finishSM8(pA0, pA1, alA, l_reg, pa); SBAR();
    SLOAD(SO, (j + SDEPTH) * KVBLK); SBAR();
    pv8<NV>(o, V_lds, pa, r32, hi); partialSM8(pB0, pB1, m_reg, mnB, alB);
    __syncthreads(); SWAIT(); SWRITE(0, SE);
    RESC(alB); __syncthreads();
    SBAR(); qkt8(pA0, pA1, K_lds, qr, r32, hi);
    finishSM8(pB0, pB1, alB, l_reg, pa); SBAR();
    if (j + 3 < NT) SLOAD(SE, (j + 1 + SDEPTH) * KVBLK); SBAR();
    pv8<NV>(o, V_lds + SHV, pa, r32, hi); partialSM8(pA0, pA1, m_reg, mnA, alA);
    __syncthreads(); SWAIT(); SWRITE(1, SO);
    RESC(alA); __syncthreads();
  }
  SBAR(); qkt8(pB0, pB1, K_lds + SHM_K8, qr, r32, hi);
  finishSM8(pA0, pA1, alA, l_reg, pa); SBAR();
  pv8<NV>(o, V_lds, pa, r32, hi); partialSM8(pB0, pB1, m_reg, mnB, alB);
  __syncthreads(); RESC(alB);
  finishSM8(pB0, pB1, alB, l_reg, pa); SBAR();
  pv8<NV>(o, V_lds + SHV, pa, r32, hi);
  if (hi == 0) li_l[r32] = l_reg; asm volatile("s_waitcnt lgkmcnt(0)" ::: "memory");
  float rli[16];
#pragma unroll
  for (int r = 0; r < 16; ++r) rli[r] = __builtin_amdgcn_rcpf(li_l[crow(r, hi)]);
  float* Ow = Ob + (long)(wid * QBLK) * LDO;
#pragma unroll
  for (int r = 0; r < 16; ++r) { int orow = crow(r, hi);
    for (int d0 = 0; d0 < 4 * NV; ++d0) Ow[(long)orow * LDO + d0 * 32 + r32] = o[d0][r] * rli[r]; }
  __syncthreads();
#undef SLOAD
#undef SWRITE
#undef SWAIT
#undef RESC
}
template <int LDQ8, int LDK8, int LDK, int LDO>
__device__ __forceinline__ void attn_dense_body_f8x2(const unsigned char* __restrict__ Qb, const unsigned char* __restrict__ Kh, const unsigned char* __restrict__ Vh, float* __restrict__ Ob, int seq, char* lds, LAS unsigned char* ldsl, int wid, int deg = 0) {
  int lane_ = lane_now(); asm volatile("" : "+v"(lane_));
  const int lane = lane_, tid = wid * 64 + lane, r32 = lane & 31, hi = lane >> 5;
  constexpr int SHV = 2 * (int)SHM_V8;
  char* V_lds = lds; char* K_lds = lds + 2 * SHV;
  float* ws = (float*)(lds + 2 * SHV + 2 * SHM_K8) + wid * 64; float* li_l = ws; float* al_l = ws + 32;
  float m_reg = -1e30f, l_reg = 0; f32x16 o[8] = {}; i32x8 qr[2];
  const unsigned char* Qw = Qb + (long)(wid * QBLK + r32) * LDQ8 + hi * 32;
#pragma unroll
  for (int ks = 0; ks < 2; ++ks) qr[ks] = cat8i(*(const u32x4*)(Qw + 64 * ks), *(const u32x4*)(Qw + 64 * ks + 16));
  const int vd = tid >> 2, vc = (tid & 3) * 16, kr = tid >> 3, kc = (tid & 7) * 16;
  const int voff = vd * LDK + vc, koff = kr * LDK8 + kc;
  u32x4 sv0, sv1, sk;
#define XLOAD(k0) do { sv0 = *(const u32x4*)(Vh + (unsigned)(voff + (k0))); sv1 = *(const u32x4*)(Vh + (unsigned)(voff + 128 * LDK + (k0))); sk = *(const u32x4*)(Kh + (unsigned)(koff + (k0) * LDK8)); } while (0)
#define XWRITE(b) do { *(u32x4*)(V_lds + (b) * SHV + VSWZ8(vd, vc)) = sv0; *(u32x4*)(V_lds + (b) * SHV + VSWZ8(vd + 128, vc)) = sv1; *(u32x4*)(K_lds + (b) * SHM_K8 + KSWZ8(kr, kc)) = sk; } while (0)
#if ATT_STAG
  const int NT = seq / KVBLK;
  XLOAD(0); asm volatile("s_waitcnt vmcnt(0)" ::: "memory"); XWRITE(0); if (1 < NT) XLOAD(KVBLK); __syncthreads();
  const int lag = wid >> 2;
  float mn, alpha = 1.f; i32x8 pa;
#define EPH(t_) do { f32x16 p0, p1; qkt8(p0, p1, K_lds + ((t_) & 1) * SHM_K8, qr, r32, hi); partialSM8(p0, p1, m_reg, mn, alpha); finishSM8(p0, p1, alpha, l_reg, pa); } while (0)
#define OPH(t_) do { if (__any(alpha < 1.f)) { if (hi == 0) al_l[r32] = alpha; asm volatile("s_waitcnt lgkmcnt(0)" ::: "memory"); \
      _Pragma("unroll") for (int d = 0; d < 8; ++d) _Pragma("unroll") for (int r = 0; r < 16; ++r) o[d][r] *= al_l[crow(r, hi)]; } \
    pv8<2>(o, V_lds + ((t_) & 1) * SHV, pa, r32, hi); } while (0)
#define STAGE(t_) do { if ((t_) + 1 < NT) { asm volatile("s_waitcnt vmcnt(0)" ::: "memory"); XWRITE(((t_) + 1) & 1); if ((t_) + 2 < NT) XLOAD(((t_) + 2) * KVBLK); } } while (0)
  if (lag == 0) {
#pragma unroll 1
    for (int t = 0; t < NT; ++t) { EPH(t); __syncthreads(); OPH(t); STAGE(t); __syncthreads(); }
    __syncthreads();
  } else {
    __syncthreads();
#pragma unroll 1
    for (int t = 0; t < NT; ++t) { EPH(t); STAGE(t); __syncthreads(); OPH(t); __syncthreads(); }
  }
#undef STAGE
#undef EPH
#undef OPH
#elif ATT_DMA
  const int NT = seq / KVBLK;
  constexpr int TB = 24576;
  unsigned kofs, vofs0, vofs1;
  {   const int krow = wid * 8 + (lane >> 3), kpc = lane & 7; kofs = (unsigned)(krow * LDK8 + ((kpc ^ ((krow >> 1) & 7)) << 4));
      const int vr0 = wid * 32 + (lane >> 2), vr1 = vr0 + 16, vpc = lane & 3;
      vofs0 = (unsigned)(vr0 * LDK + ((vpc ^ ((vr0 >> 2) & 3)) << 4)); vofs1 = (unsigned)(vr1 * LDK + ((vpc ^ ((vr1 >> 2) & 3)) << 4)); }
#define DMA_TILE(t_) do { const int b_ = (t_) & 3; const unsigned k0_ = (unsigned)(t_) * KVBLK; \
    __builtin_amdgcn_global_load_lds((const unsigned*)(Vh + (vofs0 + k0_)), (LAS unsigned*)(ldsl + b_ * TB + wid * 2048), 16, 0, 0); \
    __builtin_amdgcn_global_load_lds((const unsigned*)(Vh + (vofs1 + k0_)), (LAS unsigned*)(ldsl + b_ * TB + wid * 2048 + 1024), 16, 0, 0); \
    __builtin_amdgcn_global_load_lds((const unsigned*)(Kh + (kofs + k0_ * LDK8)), (LAS unsigned*)(ldsl + b_ * TB + 16384 + wid * 1024), 16, 0, 0); } while (0)
  float* wsd = (float*)(lds + 4 * TB) + wid * 64; float* li_d = wsd; float* al_d = wsd + 32;
#if ATT_PIPE
  DMA_TILE(0); if (1 < NT) DMA_TILE(1); if (2 < NT) DMA_TILE(2);
  if (2 < NT) asm volatile("s_waitcnt vmcnt(3)" ::: "memory"); else asm volatile("s_waitcnt vmcnt(0)" ::: "memory");
  __syncthreads();
  char* Qs = lds + 4 * TB + 2048 + wid * 4096 + lane * 32;
  *(u32x4*)(Qs) = (u32x4){(unsigned)qr[0][0], (unsigned)qr[0][1], (unsigned)qr[0][2], (unsigned)qr[0][3]}; *(u32x4*)(Qs + 16) = (u32x4){(unsigned)qr[0][4], (unsigned)qr[0][5], (unsigned)qr[0][6], (unsigned)qr[0][7]};
  *(u32x4*)(Qs + 2048) = (u32x4){(unsigned)qr[1][0], (unsigned)qr[1][1], (unsigned)qr[1][2], (unsigned)qr[1][3]}; *(u32x4*)(Qs + 2048 + 16) = (u32x4){(unsigned)qr[1][4], (unsigned)qr[1][5], (unsigned)qr[1][6], (unsigned)qr[1][7]};
  asm volatile("s_waitcnt lgkmcnt(0)" ::: "memory");
  f32x16 pA0, pA1, pB0, pB1;
  qkt8_qlds(pA0, pA1, lds + 16384, Qs, r32, hi);
#define PIPE_STEP(j_, PC0, PC1, PN0, PN1) do { const int b = (j_) & 3; const char* Vb = lds + b * TB; float mn, alpha; i32x8 pa; \
    if ((j_) + 3 < NT) DMA_TILE((j_) + 3); \
    if ((j_) + 1 < NT) qkt8_qlds(PN0, PN1, lds + (((j_) + 1) & 3) * TB + 16384, Qs, r32, hi); \
    SBAR(); partialSM8(PC0, PC1, m_reg, mn, alpha); finishSM8(PC0, PC1, alpha, l_reg, pa); \
    if (__any(alpha < 1.f)) { if (hi == 0) al_d[r32] = alpha; asm volatile("s_waitcnt lgkmcnt(0)" ::: "memory"); \
      _Pragma("unroll") for (int d = 0; d < 8; ++d) _Pragma("unroll") for (int r = 0; r < 16; ++r) o[d][r] *= al_d[crow(r, hi)]; } \
    pv8<2>(o, Vb, pa, r32, hi); \
    if ((j_) + 3 < NT) asm volatile("s_waitcnt vmcnt(3)" ::: "memory"); else asm volatile("s_waitcnt vmcnt(0)" ::: "memory");        \
    asm volatile("s_waitcnt lgkmcnt(0)" ::: "memory"); __builtin_amdgcn_s_barrier(); asm volatile("" ::: "memory"); } while (0)
#pragma unroll 1
  for (int j = 0; j < NT; j += 2) { PIPE_STEP(j, pA0, pA1, pB0, pB1); if (j + 1 < NT) PIPE_STEP(j + 1, pB0, pB1, pA0, pA1); }
#undef PIPE_STEP
#elif ATT_PAIR
  DMA_TILE(0); if (1 < NT) DMA_TILE(1);
  asm volatile("s_waitcnt vmcnt(0)" ::: "memory"); __syncthreads();
#define ONE_TILE(j_) do { const int b = (j_) & 3; const char* Vb = lds + b * TB; const char* Kb = Vb + 16384; f32x16 p0, p1; float mn, alpha; i32x8 pa; \
    qkt8(p0, p1, Kb, qr, r32, hi); partialSM8(p0, p1, m_reg, mn, alpha); finishSM8(p0, p1, alpha, l_reg, pa); \
    if (__any(alpha < 1.f)) { if (hi == 0) al_d[r32] = alpha; asm volatile("s_waitcnt lgkmcnt(0)" ::: "memory"); \
      _Pragma("unroll") for (int d = 0; d < 8; ++d) _Pragma("unroll") for (int r = 0; r < 16; ++r) o[d][r] *= al_d[crow(r, hi)]; } \
    pv8<2>(o, Vb, pa, r32, hi); } while (0)
#pragma unroll 1
  for (int j = 0; j < NT; j += 2) {
    if (j + 2 < NT) DMA_TILE(j + 2); if (j + 3 < NT) DMA_TILE(j + 3);
    ONE_TILE(j); if (j + 1 < NT) ONE_TILE(j + 1);
    asm volatile("s_waitcnt vmcnt(0) lgkmcnt(0)" ::: "memory"); __builtin_amdgcn_s_barrier(); asm volatile("" ::: "memory");
  }
#undef ONE_TILE
#else
  DMA_TILE(0); if (1 < NT) DMA_TILE(1); if (2 < NT) DMA_TILE(2);
  if (2 < NT) asm volatile("s_waitcnt vmcnt(6)" ::: "memory"); else if (1 < NT) asm volatile("s_waitcnt vmcnt(3)" ::: "memory"); else asm volatile("s_waitcnt vmcnt(0)" ::: "memory");
  __syncthreads();
#pragma unroll 1
  for (int j = 0; j < NT; ++j) { const int b = j & 3; const char* Vb = lds + b * TB; const char* Kb = Vb + 16384;
    f32x16 p0, p1; float mn, alpha; i32x8 pa;
    if (j + 3 < NT) DMA_TILE(j + 3);
#if PROBE_DEG
    if (deg == 3) { p0 = f32x16{}; p1 = f32x16{}; asm volatile("" : "+v"(p0), "+v"(p1)); } else qkt8(p0, p1, Kb, qr, r32, hi);
    if (deg == 1) { alpha = 1.f; for (int i = 0; i < 8; ++i) pa[i] = __float_as_int(p0[i] + p1[i]); } else { partialSM8(p0, p1, m_reg, mn, alpha); finishSM8(p0, p1, alpha, l_reg, pa); }
#else
    qkt8(p0, p1, Kb, qr, r32, hi);
    partialSM8(p0, p1, m_reg, mn, alpha); finishSM8(p0, p1, alpha, l_reg, pa);
#endif
    if (__any(alpha < 1.f)) { if (hi == 0) al_d[r32] = alpha; asm volatile("s_waitcnt lgkmcnt(0)" ::: "memory");
#pragma unroll
      for (int d = 0; d < 8; ++d)
#pragma unroll
        for (int r = 0; r < 16; ++r) o[d][r] *= al_d[crow(r, hi)]; }
#if PROBE_DEG
    if (deg != 2)
#endif
    pv8<2>(o, Vb, pa, r32, hi);
    if (j + 3 < NT) asm volatile("s_waitcnt vmcnt(6)" ::: "memory"); else if (j + 2 < NT) asm volatile("s_waitcnt vmcnt(3)" ::: "memory"); else asm volatile("s_waitcnt vmcnt(0)" ::: "memory");
    asm volatile("s_waitcnt lgkmcnt(0)" ::: "memory"); __builtin_amdgcn_s_barrier(); asm volatile("" ::: "memory");
  }
#endif
  li_l = li_d;
#undef DMA_TILE
#else
  const int NT = seq / KVBLK;
  u32x4 tv0, tv1, tk;
#define YLOAD(k0) do { tv0 = *(const u32x4*)(Vh + (unsigned)(voff + (k0))); tv1 = *(const u32x4*)(Vh + (unsigned)(voff + 128 * LDK + (k0))); tk = *(const u32x4*)(Kh + (unsigned)(koff + (k0) * LDK8)); } while (0)
#define YWRITE(b) do { *(u32x4*)(V_lds + (b) * SHV + VSWZ8(vd, vc)) = tv0; *(u32x4*)(V_lds + (b) * SHV + VSWZ8(vd + 128, vc)) = tv1; *(u32x4*)(K_lds + (b) * SHM_K8 + KSWZ8(kr, kc)) = tk; } while (0)
#define TILE_BODY(j_) do { const int cur = (j_) & 1; f32x16 p0, p1; float mn, alpha; i32x8 pa; \
    qkt8(p0, p1, K_lds + cur * SHM_K8, qr, r32, hi); \
    if ((j_) + 1 < NT) { asm volatile("s_waitcnt vmcnt(3)" ::: "memory"); if (cur) { XWRITE(0); if ((j_) + 3 < NT) XLOAD(((j_) + 3) * KVBLK); } else { YWRITE(1); if ((j_) + 3 < NT) YLOAD(((j_) + 3) * KVBLK); } } \
    partialSM8(p0, p1, m_reg, mn, alpha); finishSM8(p0, p1, alpha, l_reg, pa); \
    if (__any(alpha < 1.f)) { if (hi == 0) al_l[r32] = alpha; asm volatile("s_waitcnt lgkmcnt(0)" ::: "memory"); \
      _Pragma("unroll") for (int d = 0; d < 8; ++d) _Pragma("unroll") for (int r = 0; r < 16; ++r) o[d][r] *= al_l[crow(r, hi)]; } \
    pv8<2>(o, V_lds + cur * SHV, pa, r32, hi); \
    __syncthreads(); } while (0)
  XLOAD(0); asm volatile("s_waitcnt vmcnt(0)" ::: "memory"); XWRITE(0); if (1 < NT) YLOAD(KVBLK); if (2 < NT) XLOAD(2 * KVBLK); __syncthreads();
#pragma unroll 1
  for (int j = 0; j < NT; j += 2) { TILE_BODY(j); if (j + 1 < NT) TILE_BODY(j + 1); }
#undef TILE_BODY
#undef YLOAD
#undef YWRITE
#endif
  if (hi == 0) li_l[r32] = l_reg; asm volatile("s_waitcnt lgkmcnt(0)" ::: "memory");
  float rli[16];
#pragma unroll
  for (int r = 0; r < 16; ++r) rli[r] = __builtin_amdgcn_rcpf(li_l[crow(r, hi)]);
  float* Ow = Ob + (long)(wid * QBLK) * LDO;
#pragma unroll
  for (int r = 0; r < 16; ++r) { int orow = crow(r, hi);
#pragma unroll
    for (int d0 = 0; d0 < 8; ++d0) Ow[(long)orow * LDO + d0 * 32 + r32] = o[d0][r] * rli[r]; }
  __syncthreads();
#undef XLOAD
#undef XWRITE
}
#undef VSWZ8
#undef KSWZ8
#undef KSWZ
#undef SBAR
}

struct Args { const float* in[36]; float* out; unsigned char* ws; int ph_lo, ph_hi, li, pad; };
__device__ __forceinline__ int rowmap(int mode, int n) {
    if (mode == 1) { if (n >= 2560 && n < 4608) return (n & ~63) + 2 * (n & 31) + ((n >> 5) & 1); return n; }
    if (mode == 2) return (n >> 7) * 256 + (n & 127);
    if (mode == 3) return (n >> 7) * 256 + 128 + (n & 127);
    return n;
}
__device__ __forceinline__ void tr_tile(const float* __restrict__ W, int ldn, int k0, int n0, bf16* __restrict__ WT, int Kd, int mode, LAS float* scr, int lane) {
    f32x4 v[16];
    const float* src = W + (size_t)(k0 + (lane >> 4)) * ldn + n0 + (lane & 15) * 4;
#pragma unroll
    for (int i = 0; i < 16; ++i) v[i] = __builtin_nontemporal_load((const f32x4*)(src + (size_t)(4 * i) * ldn));
#pragma unroll
    for (int i = 0; i < 16; ++i) { LAS float* d = scr + (4 * i + (lane >> 4)) * 65 + (lane & 15) * 4; d[0] = v[i][0]; d[1] = v[i][1]; d[2] = v[i][2]; d[3] = v[i][3]; }
    LDS_WAIT();
    const int c = lane >> 3, nn = lane & 7;
#pragma unroll
    for (int j = 0; j < 8; ++j) { const int n = nn + 8 * j; const LAS float* s = scr + (8 * c) * 65 + n;
        u32x4 o; o.x = pk_bf16(s[0], s[65]); o.y = pk_bf16(s[130], s[195]); o.z = pk_bf16(s[260], s[325]); o.w = pk_bf16(s[390], s[455]);
        *(u32x4*)(WT + (size_t)rowmap(mode, n0 + n) * Kd + k0 + 8 * c) = o; }
    LDS_WAIT();
}
constexpr float W8_SCALE = 64.0f;
__device__ __forceinline__ void cvt_store8(const f32x4 (&v)[16], unsigned char* __restrict__ dstk, int Kd, int mode, int n0, int lane) {
    const int r = lane >> 3, c = lane & 7;
#pragma unroll
    for (int j = 0; j < 4; ++j) { int w[4];
#pragma unroll
        for (int q = 0; q < 4; ++q) { int t = 0; t = __builtin_amdgcn_cvt_pk_fp8_f32(v[4 * q][j] * W8_SCALE, v[4 * q + 1][j] * W8_SCALE, t, false);
            t = __builtin_amdgcn_cvt_pk_fp8_f32(v[4 * q + 2][j] * W8_SCALE, v[4 * q + 3][j] * W8_SCALE, t, true); w[q] = t; }
        __builtin_nontemporal_store((u32x4){(unsigned)w[0], (unsigned)w[1], (unsigned)w[2], (unsigned)w[3]}, (u32x4*)(dstk + (size_t)rowmap(mode, n0 + 4 * c + j) * Kd + 16 * r)); }
}
__device__ __forceinline__ void tr_tile8(const float* __restrict__ W, int ldn, int k0, int n0, unsigned char* __restrict__ WT, int Kd, int mode, LAS float* scr, int lane) {
    f32x4 v[16];
    const float* src = W + (size_t)(k0 + 16 * (lane >> 3)) * ldn + n0 + (lane & 7) * 4;
#pragma unroll
    for (int i = 0; i < 16; ++i) v[i] = __builtin_nontemporal_load((const f32x4*)(src + (size_t)i * ldn));
    cvt_store8(v, WT + k0, Kd, mode, n0, lane);
}
constexpr int TI_WIN = 32 * 88, TI_WOUT = 32 * 32, TI_EXP = 256;
constexpr int TI_W3 = 32;
constexpr int TI_LAYER = TI_WIN + TI_WOUT + TI_W3;
constexpr int TI_MOE = 3 * NEX1 * TI_EXP;
__device__ __forceinline__ void tr_item(const Args& a, int it, LAS float* scr, int lane) {
    const int l = it / TI_LAYER; int r = it % TI_LAYER; unsigned char* ws = wsb();
    if (r < TI_W3) { tr_tile(inp(I_HYW3) + (size_t)l * 64 * 2048, 2048, 0, r * 64, (bf16*)(ws + WS_W3T) + (size_t)l * 2048 * 64, 64, 0, scr, lane); return; }
    r -= TI_W3;
    if (r < TI_WIN) {
        const float* W = inp(I_WIN) + (size_t)l * DM * DIN; unsigned char* base = ws + WS_WINT + (size_t)l * DIN * DM * 2;
        if (r < 768) {
#if F8_HY
            const int kb = r / 48, nb = r % 48; tr_tile8(W, DIN, kb * 128, nb * 32, base, DM, 1, scr, lane);
#else
            const int kb = r / 24, nb = r % 24; tr_tile(W, DIN, kb * 64, nb * 64, (bf16*)base, DM, 1, scr, lane);
#endif
        } else { r -= 768;
            unsigned char* rb = base + (size_t)NHY * DM * 2;
            const int blk = r / 32, j = r % 32, c0 = blk * 64;
            if (c0 >= F8_C0 && c0 < F8_C1) { const int hf = j / 16, kb = j % 16;
                tr_tile8(W, DIN, kb * 128, NHY + c0 + hf * 32, rb + (size_t)F8_C0 * DM - (size_t)NHY * DM, DM, 1, scr, lane); }
            else tr_tile(W, DIN, j * 64, NHY + c0, (bf16*)rb - (size_t)NHY * DM, DM, 1, scr, lane);
        }
        return; }
    r -= TI_WIN;
    {
#if FP8_OUT
        const int kb = r / 64, nb = r % 64; tr_tile8(inp(I_WOUT) + (size_t)l * DM * DM, DM, kb * 128, nb * 32, ws + WS_WOUTT + (size_t)l * DM * DM, DM, 0, scr, lane); return; }
#else
        const int kb = r / 32, nb = r % 32; tr_tile(inp(I_WOUT) + (size_t)l * DM * DM, DM, kb * 64, nb * 64, (bf16*)(ws + WS_WOUTT) + (size_t)l * DM * DM, DM, 0, scr, lane); return; }
#endif
}
struct MoeTile { const float* src; int ldn; unsigned char* dst; int Kd; int mode; int n0; };
struct MoePtrs { const float* ewg; const float* ewu; const float* ewd; const float* swg; const float* swu; const float* swd; unsigned char* ws; };
__device__ __forceinline__ MoePtrs moe_ptrs() { MoePtrs p; p.ewg = inp(I_EWG); p.ewu = inp(I_EWU); p.ewd = inp(I_EWD); p.swg = inp(I_SWG); p.swu = inp(I_SWU); p.swd = inp(I_SWD); p.ws = wsb(); return p; }
__device__ __forceinline__ MoeTile moe_tile(const MoePtrs& P, int l, int r) {
    MoeTile m; unsigned char* ws = P.ws;
    const int kind = r / (NEX1 * TI_EXP); r %= (NEX1 * TI_EXP); const int e = r / TI_EXP, t = r % TI_EXP;
    if (kind < 2) {
        const float* W = (e < NEXP) ? (kind == 0 ? P.ewg : P.ewu) + ((size_t)l * NEXP + e) * DM * DEXP : (kind == 0 ? P.swg : P.swu) + (size_t)l * DM * DEXP;
        const int kb = t / 16, nb = t % 16;
        m.src = W + (size_t)(kb * 128) * DEXP + nb * 32; m.ldn = DEXP; m.dst = ws + WS_W1T + ((size_t)l * NEX1 + e) * 1024 * DM + kb * 128; m.Kd = DM; m.mode = 2 + kind; m.n0 = nb * 32;
    } else {
        const float* W = (e < NEXP) ? P.ewd + ((size_t)l * NEXP + e) * DEXP * DM : P.swd + (size_t)l * DEXP * DM;
        const int kb = t / 64, nb = t % 64;
        m.src = W + (size_t)(kb * 128) * DM + nb * 32; m.ldn = DM; m.dst = ws + WS_W2T + ((size_t)l * NEX1 + e) * DM * DEXP + kb * 128; m.Kd = DEXP; m.mode = 0; m.n0 = nb * 32;
    }
    return m;
}
#define MOE_LOAD(dstv, tile) do { const MoeTile m_ = moe_tile(P_, l, (tile)); const float* src_ = m_.src + (size_t)(16 * (lane >> 3)) * m_.ldn + (lane & 7) * 4; \
        _Pragma("unroll") for (int i = 0; i < 16; ++i) dstv[i] = __builtin_nontemporal_load((const f32x4*)(src_ + (size_t)i * m_.ldn)); } while (0)
#define MOE_PUT(srcv, tile) do { const MoeTile m_ = moe_tile(P_, l, (tile)); cvt_store8(srcv, m_.dst, m_.Kd, m_.mode, m_.n0, lane); } while (0)
__device__ __forceinline__ void moe_conv_range(int l, int it, const int stride, const int end, int lane) {
    f32x4 va[16], vb[16];
    if (it >= end) return;
    const MoePtrs P_ = moe_ptrs();
    MOE_LOAD(va, it);
    for (;;) {
        {   const int nx = (it + stride < end) ? it + stride : it; MOE_LOAD(vb, nx); }
        MOE_PUT(va, it);
        it += stride; if (it >= end) break;
        {   const int nx = (it + stride < end) ? it + stride : it; MOE_LOAD(va, nx); }
        MOE_PUT(vb, it);
        it += stride; if (it >= end) break;
    }
}
constexpr int INP_A = 0, INP_B = 0, INP_N = (100 * INP_A + 20 * INP_B) * NWAVES, TI_MIX = TI_MOE - INP_N;
__device__ __forceinline__ void moe_conv_inproj(int l, int G, int bid, int wave, int lane) {
    asm volatile("" : "+v"(lane));
    if (G != 256) { moe_conv_range(l, TI_MIX + bid * NWAVES + wave, G * NWAVES, TI_MOE, lane); return; }
    if (bid >= 136 && bid < 236) moe_conv_range(l, TI_MIX + (bid - 136) * NWAVES + wave, 100 * NWAVES, TI_MIX + 100 * INP_A * NWAVES, lane);
    else if (bid >= 236) moe_conv_range(l, TI_MIX + 100 * INP_A * NWAVES + (bid - 236) * NWAVES + wave, 20 * NWAVES, TI_MOE, lane);
}
__device__ __forceinline__ void moe_conv(int l, LAS unsigned char* lds, int G, int bid, int wave, int lane) {
    asm volatile("" : "+v"(lane));
    const int NGW = G * NWAVES, gw = bid * NWAVES + wave;
    const int def = (G > 64) ? ((l == NLAYER - 1) ? 4 : 6) : 0;
    const int a = TI_MIX / NGW;
    const int n1 = (a - def) * NGW;
    moe_conv_range(l, gw, NGW, n1, lane);
    if (def == 0) moe_conv_range(l, n1 + gw, NGW, TI_MIX, lane);
    else if (bid >= 32) moe_conv_range(l, n1 + (bid - 32) * NWAVES + wave, (G - 32) * NWAVES, TI_MIX, lane);
}
__device__ __forceinline__ void ada_unit(const Args& a, int u, LAS unsigned char* lds, int tid, int wave, int lane) {
    const int l = u / 96, cbk = u % 96;
    LAS float* sv = (LAS float*)lds; LAS float* red = sv + 3 * DM;
    for (int i = tid; i < 3 * DM; i += NTHR) { const int r = i / DM, k = i % DM; const float cv = (r < 2) ? inp(I_C)[r * DM + k] : inp(I_CCTX)[k]; sv[i] = silu_f(cv); }
    __syncthreads();
    const float* W = inp(I_ADAW) + (size_t)l * DM * (6 * DM) + cbk * 128 + (lane & 31) * 4;
    f32x4 acc0 = {0.f, 0.f, 0.f, 0.f}, acc1 = acc0, acc2 = acc0;
    const int kb = wave * 256 + (lane >> 5);
#pragma unroll 8
    for (int i = 0; i < 128; ++i) { const int k = kb + 2 * i; const f32x4 w = __builtin_nontemporal_load((const f32x4*)(W + (size_t)k * (6 * DM)));
        acc0 += w * sv[k]; acc1 += w * sv[DM + k]; acc2 += w * sv[2 * DM + k]; }
#pragma unroll
    for (int j = 0; j < 4; ++j) { acc0[j] = half_sum(acc0[j]); acc1[j] = half_sum(acc1[j]); acc2[j] = half_sum(acc2[j]); }
    if (lane < 32) {
#pragma unroll
        for (int j = 0; j < 4; ++j) { red[(wave * 3 + 0) * 128 + lane * 4 + j] = acc0[j]; red[(wave * 3 + 1) * 128 + lane * 4 + j] = acc1[j]; red[(wave * 3 + 2) * 128 + lane * 4 + j] = acc2[j]; } }
    __syncthreads();
    if (tid < 384) { const int r = tid / 128, cc = tid % 128; float s = inp(I_ADAB)[(size_t)l * 6 * DM + cbk * 128 + cc];
#pragma unroll
        for (int w = 0; w < 8; ++w) s += red[(w * 3 + r) * 128 + cc];
        ((float*)(wsb() + WS_MOD))[((size_t)l * 3 + r) * (6 * DM) + cbk * 128 + cc] = s; }
    __syncthreads();
}
__device__ __forceinline__ void hid_item(const Args& a, int it, int lane) {
    int l, n, pos; bf16* out;
    if (it < NLAYER * SEQ) { l = it / SEQ; pos = it % SEQ; n = SEQ; out = (bf16*)(wsb() + WS_HIDB) + ((size_t)l * RB + pos) * 64; }
    else { const int r = it - NLAYER * SEQ; l = r / CTXL; pos = r % CTXL; n = CTXL; out = (bf16*)(wsb() + WS_HIDB) + ((size_t)l * RB + SEQ + pos) * 64; }
    const float* w1 = inp(I_HYW1) + (size_t)l * 17 * 64; const float* w2 = inp(I_HYW2) + (size_t)l * 64 * 64;
    const float fq = inp(I_HYFREQ)[l * 64 + lane];
    const float tt = (float)pos / (float)(n - 1);
    float pre = inp(I_HYB1)[l * 64 + lane] + tt * w1[lane];
#pragma unroll
    for (int i = 0; i < 8; ++i) { const float band = 1e-4f + (float)i * ((7.0f - 1e-4f) / 7.0f); float rev = ((float)pos * band) / (float)n; rev -= floorf(rev);
        const float cs = __builtin_amdgcn_cosf(rev), sn = __builtin_amdgcn_sinf(rev);
        pre += cs * w1[(1 + i) * 64 + lane] - sn * w1[(9 + i) * 64 + lane]; }
    const float h1 = sin_rad(fq * pre);
    float pre2 = inp(I_HYB2)[l * 64 + lane];
#pragma unroll 16
    for (int i = 0; i < 64; ++i) pre2 += __shfl(h1, i) * w2[i * 64 + lane];
    out[lane] = f2bf(sin_rad(fq * pre2));
}
__device__ __forceinline__ void p0_prologue(const Args& a, LAS unsigned char* lds, int G, int bid, int tid, int wave, int lane) {
    for (int u = bid; u < NLAYER * 96; u += G) ada_unit(a, u, lds, tid, wave, lane);
    const int gw = bid * NWAVES + wave, NGW = G * NWAVES;
    for (int it = gw; it < NLAYER * (SEQ + CTXL); it += NGW) hid_item(a, it, lane);
    if (bid == G - 1) {
        float* rope = (float*)(wsb() + WS_ROPE);
        for (int i = tid; i < 64 * 32; i += NTHR) { const int pos = i >> 5, f = i & 31; const float inv = __builtin_amdgcn_exp2f(-(float)f * (13.287712379549449f / 32.0f));
            const float ang = (float)pos * inv; float rev = ang * 0.15915494309189535f; rev -= floorf(rev);
            rope[2 * i] = __builtin_amdgcn_cosf(rev); rope[2 * i + 1] = __builtin_amdgcn_sinf(rev); }
        if (wave < NLAYER) { const float* lv = inp(I_ATTLAM) + (size_t)wave * 4 * 128;
            float s1 = lv[lane] * lv[128 + lane] + lv[64 + lane] * lv[192 + lane], s2 = lv[256 + lane] * lv[384 + lane] + lv[320 + lane] * lv[448 + lane];
            s1 = wave_sum(s1); s2 = wave_sum(s2);
            const float lam_init = 0.8f - 0.6f * fast_exp(-0.3f * (float)wave);
            if (lane == 0) ((float*)(wsb() + WS_LAMS))[wave] = fast_exp(s1) - fast_exp(s2) + lam_init; }
    }
    for (int i = (bid * NWAVES + wave) * 64 + lane; i < 8192; i += G * NTHR) { int r, k, den;
        if (i < 64) { r = 1 + i / 8; k = i % 8; den = 64; if (r > 7) { r = 0; } }
        else if (i < 512) { r = 1 + (i - 64) / 64; k = (i - 64) % 64; den = 512; }
        else { r = 1 + (i - 512) / 512; k = (i - 512) % 512; den = 8192; }
        float rev = -(float)(r * k) / (float)den; rev -= rintf(rev);
        ((f32x2*)(wsb() + WS_TW))[i] = (f32x2){__builtin_amdgcn_cosf(rev), __builtin_amdgcn_sinf(rev)}; }
    for (int i = (bid * NWAVES + wave) * 64 + lane; i < NLAYER * NEXP * DM; i += G * NTHR) { const int l = i / (NEXP * DM), e = (i / DM) % NEXP, k = i % DM;
        const float w = inp(I_RW)[((size_t)l * DM + k) * NEXP + e]; const bf16 hi = f2bf(w); const bf16 lo = f2bf(w - bf2f(hi));
        bf16* T = (bf16*)(wsb() + WS_RWT) + (size_t)l * 2 * NEXP * DM; T[(size_t)e * DM + k] = hi; T[(size_t)(NEXP + e) * DM + k] = lo; }
    LAS float* scr = (LAS float*)(lds + wave * (64 * 65 * 4));
    {   constexpr int NIT = NLAYER * TI_LAYER; const int n_ada = NLAYER * 96, n_free = G - n_ada;
        int n1 = NIT;
        if (n_free > 0) { const int xa = (NIT + 64 * n_ada) / G - 64; n1 = xa > 0 ? xa * G : 0; if (n1 > NIT) n1 = NIT; }
        for (int it = gw; it < n1; it += NGW) tr_item(a, it, scr, lane);
        if (n_free > 0 && bid >= n_ada) for (int it = n1 + (bid - n_ada) * NWAVES + wave; it < NIT; it += n_free * NWAVES) tr_item(a, it, scr, lane); }
}

__device__ __forceinline__ void p_filt(int l, int G, int bid, int wave, int lane) {
    asm volatile("" : "+v"(lane));
    const bf16* W3T = (const bf16*)(wsb() + WS_W3T) + (size_t)l * 2048 * 64; const bf16* HB = (const bf16*)(wsb() + WS_HIDB) + (size_t)l * RB * 64;
    float* F = (float*)(wsb() + WS_FILT) + (size_t)l * 2048 * RB;
    const int fr = lane & 15, fq = lane >> 4;
    for (int it = (G - 1 - bid) * NWAVES + wave; it < 64 * 68; it += G * NWAVES) { const int fc0 = (it / 68) * 32, lg0 = (it % 68) * 64;
        bf16x8 af[2][2], bfm[4][2];
#pragma unroll
        for (int mt = 0; mt < 2; ++mt)
#pragma unroll
            for (int ks = 0; ks < 2; ++ks) af[mt][ks] = *(const bf16x8*)(W3T + (size_t)(fc0 + 16 * mt + fr) * 64 + 8 * fq + 32 * ks);
#pragma unroll
        for (int nt = 0; nt < 4; ++nt)
#pragma unroll
            for (int ks = 0; ks < 2; ++ks) bfm[nt][ks] = *(const bf16x8*)(HB + (size_t)(lg0 + 16 * nt + fr) * 64 + 8 * fq + 32 * ks);
#pragma unroll
        for (int mt = 0; mt < 2; ++mt)
#pragma unroll
            for (int nt = 0; nt < 4; ++nt) { f32x4 c = {0.f, 0.f, 0.f, 0.f};
#pragma unroll
                for (int ks = 0; ks < 2; ++ks) c = __builtin_amdgcn_mfma_f32_16x16x32_bf16(bfm[nt][ks], af[mt][ks], c, 0, 0, 0);
                *(f32x4*)(F + (size_t)(fc0 + 16 * mt + fr) * RB + lg0 + 16 * nt + 4 * fq) = c; }
    }
}
__device__ __forceinline__ void p_ln1(const Args& a, int l, int G, int bid, int wave, int lane) {
    asm volatile("" : "+v"(lane));
    const float* mod = (const float*)(wsb() + WS_MOD) + (size_t)l * 3 * (6 * DM);
    bf16* A1 = (bf16*)(wsb() + WS_A1);
    for (int r = bid * NWAVES + wave; r < M; r += G * NWAVES) {
        const float* xr = (l == 0) ? xin_row(inp(I_X), inp(I_CTX), r) : (const float*)(wsb() + WS_XB) + (size_t)r * DM;
        const float* mv = mod + (size_t)row_mod(r) * (6 * DM);
        f32x4 v[8]; float s = 0.f;
#pragma unroll
        for (int j = 0; j < 8; ++j) { v[j] = __builtin_nontemporal_load((const f32x4*)xr + lane + 64 * j); s += (v[j][0] + v[j][1]) + (v[j][2] + v[j][3]); }
        const float mean = wave_sum(s) * (1.f / DM); float s2 = 0.f;
#pragma unroll
        for (int j = 0; j < 8; ++j) { v[j] = v[j] - mean; s2 += (v[j][0] * v[j][0] + v[j][1] * v[j][1]) + (v[j][2] * v[j][2] + v[j][3] * v[j][3]); }
        const float rstd = 1.f / sqrtf(wave_sum(s2) * (1.f / DM) + LN_EPS);
        f32x4 shv[8], scv[8];
#pragma unroll
        for (int j = 0; j < 8; ++j) { shv[j] = ((const f32x4*)mv)[lane + 64 * j]; scv[j] = ((const f32x4*)(mv + DM))[lane + 64 * j]; }
#pragma unroll
        for (int j = 0; j < 8; ++j) { const f32x4 sh = shv[j], sc = scv[j];
            const f32x4 o = v[j] * rstd * (sc + 1.f) + sh;
#if NEED_A1F
            {   int w8 = 0; w8 = cvt2_fp8(o[0], o[1], w8, false); w8 = cvt2_fp8(o[2], o[3], w8, true); ((unsigned*)(wsb() + WS_A1F + (size_t)r * DM))[lane + 64 * j] = (unsigned)w8; }
#endif
#if NEED_A1B
            {   u32x2 w; w.x = pk_bf16(o[0], o[1]); w.y = pk_bf16(o[2], o[3]); ((u32x2*)(A1 + (size_t)r * DM))[lane + 64 * j] = w; }
#endif
        }
    }
}

constexpr int FN = 8192;
__device__ __forceinline__ f32x2 zero2() { float z = 0.f; asm volatile("" : "+v"(z)); return (f32x2){z, z}; }
__device__ __forceinline__ f32x2 cmul(f32x2 a, f32x2 b) { return (f32x2){a.x * b.x - a.y * b.y, a.x * b.y + a.y * b.x}; }
#define PADI(i) ((i) + ((i) >> 5))
constexpr int FNP = FN + FN / 32;
__device__ __forceinline__ void dft4(f32x2& v0, f32x2& v1, f32x2& v2, f32x2& v3) { const f32x2 a0 = v0 + v2, a1 = v0 - v2, a2 = v1 + v3, t = v1 - v3; const f32x2 a3 = {t.y, -t.x}; v0 = a0 + a2; v1 = a1 + a3; v2 = a0 - a2; v3 = a1 - a3; }
__device__ __forceinline__ void dft8(f32x2 (&a)[8]) {
    const float R = 0.70710678118654752f;
    f32x2 b0 = a[0] + a[4], b4 = a[0] - a[4];
    f32x2 b1 = a[1] + a[5]; const f32x2 t1 = a[1] - a[5]; f32x2 b5 = {(t1.x + t1.y) * R, (t1.y - t1.x) * R};
    f32x2 b2 = a[2] + a[6]; const f32x2 t2 = a[2] - a[6]; f32x2 b6 = {t2.y, -t2.x};
    f32x2 b3 = a[3] + a[7]; const f32x2 t3 = a[3] - a[7]; f32x2 b7 = {(t3.y - t3.x) * R, (-t3.x - t3.y) * R};
    dft4(b0, b1, b2, b3); dft4(b4, b5, b6, b7);
    a[0] = b0; a[2] = b1; a[4] = b2; a[6] = b3; a[1] = b4; a[3] = b5; a[5] = b6; a[7] = b7;
}
__device__ __forceinline__ void dft16(f32x2 (&a)[16]) {
    const float C1 = 0.92387953251128674f, S1 = 0.38268343236508977f, R = 0.70710678118654752f;
    f32x2 lo[8], hi[8];
#pragma unroll
    for (int r = 0; r < 8; ++r) { lo[r] = a[r] + a[r + 8]; hi[r] = a[r] - a[r + 8]; }
    hi[1] = cmul(hi[1], (f32x2){C1, -S1}); hi[2] = (f32x2){(hi[2].x + hi[2].y) * R, (hi[2].y - hi[2].x) * R}; hi[3] = cmul(hi[3], (f32x2){S1, -C1});
    hi[4] = (f32x2){hi[4].y, -hi[4].x}; hi[5] = cmul(hi[5], (f32x2){-S1, -C1}); hi[6] = (f32x2){(hi[6].y - hi[6].x) * R, (-hi[6].x - hi[6].y) * R}; hi[7] = cmul(hi[7], (f32x2){-C1, -S1});
    dft8(lo); dft8(hi);
#pragma unroll
    for (int m = 0; m < 8; ++m) { a[2 * m] = lo[m]; a[2 * m + 1] = hi[m]; }
}
#define LDS_BARRIER() do { asm volatile("s_waitcnt lgkmcnt(0)" ::: "memory"); __builtin_amdgcn_s_barrier(); asm volatile("" ::: "memory"); } while (0)
template <int Ns, bool ZIN = false> __device__ __forceinline__ void fft_pass8(LAS f32x2* buf, const f32x2 (&w)[2][7], int tid) {
    f32x2 v[2][8];
#pragma unroll
    for (int q = 0; q < 2; ++q) { const int j = tid + NTHR * q;
#pragma unroll
        for (int r = 0; r < 8; ++r) v[q][r] = (ZIN && r >= 4) ? (f32x2){0.f, 0.f} : buf[PADI(j + r * (FN / 8))];
        if (Ns > 1) {
#pragma unroll
            for (int r = 1; r < 8; ++r) v[q][r] = cmul(v[q][r], w[q][r - 1]); }
        dft8(v[q]); }
    LDS_BARRIER();
#pragma unroll
    for (int q = 0; q < 2; ++q) { const int j = tid + NTHR * q, k = j & (Ns - 1), j0 = ((j - k) << 3) + k;
#pragma unroll
        for (int m = 0; m < 8; ++m) buf[PADI(j0 + m * Ns)] = v[q][m]; }
    LDS_BARRIER();
}
template <int Ns> __device__ __forceinline__ void tw_load8(f32x2 (&w)[2][7], const f32x2* tw, int tid) {
#pragma unroll
    for (int q = 0; q < 2; ++q) { const int k = (tid + NTHR * q) & (Ns - 1);
#pragma unroll
        for (int r = 1; r < 8; ++r) w[q][r - 1] = tw[(r - 1) * Ns + k]; }
}
template <bool ZIN, bool LOUT> __device__ __forceinline__ void fft8192(LAS f32x2* buf, int tid) {
    asm volatile("" : "+v"(tid));
    const f32x2* tw = (const f32x2*)(wsb() + WS_TW);
    f32x2 wA[2][7], wB[2][7];
    tw_load8<8>(wA, tw, tid);
    fft_pass8<1, ZIN>(buf, wA, tid);
    tw_load8<64>(wB, tw + 64, tid);
    fft_pass8<8>(buf, wA, tid);
    {   f32x2 v[16], w[15];
#pragma unroll
        for (int r = 1; r < 16; ++r) w[r - 1] = tw[512 + (r - 1) * 512 + tid];
        fft_pass8<64>(buf, wB, tid);
#pragma unroll
        for (int r = 0; r < 16; ++r) v[r] = buf[PADI(tid + r * 512)];
#pragma unroll
        for (int r = 1; r < 16; ++r) v[r] = cmul(v[r], w[r - 1]);
        dft16(v);
        LDS_BARRIER();
#pragma unroll
        for (int m = 0; m < (LOUT ? 8 : 16); ++m) buf[PADI(tid + m * 512)] = v[m];
        LDS_BARRIER(); }
}
__device__ __forceinline__ float block_sum(float v, LAS float* red, int tid, int wave, int lane) {
    v = wave_sum(v); __syncthreads(); if (lane == 0) red[wave] = v; __syncthreads();
    float s = 0.f;
#pragma unroll
    for (int w = 0; w < NWAVES; ++w) s += red[w];
    return s;
}
__device__ __forceinline__ float hy_decay(int c) { const float mn = -3.0701134573253945f, mx = -15.350567286626973f; return -(mn + (mx - mn) * ((float)c / 511.0f)); }
__device__ __forceinline__ float hy_conv3(const bf16* rowp, int t, int n, float w0, float w1, float w2, float bias) {
    const float um = bf2f(rowp[t > 0 ? t - 1 : 0]), u0 = bf2f(rowp[t]), up = bf2f(rowp[t + 1 < n ? t + 1 : t]);
    return w0 * (t > 0 ? um : 0.f) + w1 * u0 + w2 * (t + 1 < n ? up : 0.f) + bias;
}
struct HyTaps { bf16 um, u0, up; };
__device__ __forceinline__ HyTaps hy_taps(const bf16* rowp, int t, int n) { HyTaps r; r.um = rowp[t > 0 ? t - 1 : 0]; r.u0 = rowp[t]; r.up = rowp[t + 1 < n ? t + 1 : t]; return r; }
__device__ __forceinline__ float hy_apply(const HyTaps& r, int t, int n, float w0, float w1, float w2, float bias) { return w0 * (t > 0 ? bf2f(r.um) : 0.f) + w1 * bf2f(r.u0) + w2 * (t + 1 < n ? bf2f(r.up) : 0.f) + bias; }
__device__ __forceinline__ void hyena_lat_unit(const Args& a, int l, int c, LAS unsigned char* lds, int tid, int wave, int lane) {
    asm volatile("" : "+v"(tid), "+v"(lane));
    LAS f32x2* ZB = (LAS f32x2*)lds; LAS f32x2* GH = ZB + FNP; LAS float* red = (LAS float*)(GH + FNP);
    const float* F = (const float*)(wsb() + WS_FILT) + (size_t)l * 2048 * RB + (size_t)c * RB;
    const float dec = hy_decay(c);
    float s0 = 0.f, s1 = 0.f;
    const bf16* HYT = (const bf16*)(wsb() + WS_HYT);
    const float* cw = inp(I_HYCW) + (size_t)l * 3 * NHY; const float* cbias = inp(I_HYCB) + (size_t)l * NHY;
    HyTaps zt[8][2];
#pragma unroll
    for (int q = 0; q < 8; ++q) { const int t = tid + NTHR * q; zt[q][0] = hy_taps(HYT + (size_t)(1024 + c) * M + CTXL, t, SEQ); zt[q][1] = hy_taps(HYT + (size_t)(1024 + c) * M + RB + CTXL, t, SEQ); }
    float fv[8][4];
#pragma unroll
    for (int q = 0; q < 8; ++q) { const int t = tid + NTHR * q; fv[q][0] = __builtin_nontemporal_load(F + t); fv[q][1] = __builtin_nontemporal_load(F + (size_t)512 * RB + t); fv[q][2] = __builtin_nontemporal_load(F + (size_t)1024 * RB + t); fv[q][3] = __builtin_nontemporal_load(F + (size_t)1536 * RB + t); }
#pragma unroll
    for (int q = 0; q < 8; ++q) { const int t = tid + NTHR * q;
        const float dm = fast_exp(-((float)t / 4095.0f) * dec);
        const float a0 = fv[q][0] * dm, a1 = fv[q][1] * dm, a2 = fv[q][2] * dm, a3 = fv[q][3] * dm;
        GH[PADI(t)] = (f32x2){a0, a1}; s0 += fabsf(a0); s1 += fabsf(a1);
        if (t >= 1) { GH[PADI(FN - t)] = (f32x2){a2, a3}; s0 += fabsf(a2); s1 += fabsf(a3); }
        if (t == 0) GH[PADI(FN / 2)] = zero2(); }
    const float S0 = block_sum(s0, red, tid, wave, lane); const float S1 = block_sum(s1, red, tid, wave, lane);
    __syncthreads();
    fft8192<false, false>(GH, tid);
    const float i0 = 0.5f / S0, i1 = 0.5f / S1;
    float z[8][2];
    {   const int ch = 1024 + c; const float w0 = cw[ch], w1 = cw[NHY + ch], w2 = cw[2 * NHY + ch], bb = cbias[ch];
#pragma unroll
        for (int q = 0; q < 8; ++q) { const int t = tid + NTHR * q;
#pragma unroll
            for (int b = 0; b < 2; ++b) z[q][b] = hy_apply(zt[q][b], t, SEQ, w0, w1, w2, bb);
            ZB[PADI(t)] = (f32x2){z[q][0], z[q][1]}; } }
    __syncthreads();
    for (int o = 0; o < 2; ++o) {
        fft8192<true, false>(ZB, tid);
#pragma unroll 4
        for (int q = 0; q < 16; ++q) { const int k = tid + NTHR * q; const f32x2 g = GH[PADI(k)], gm = GH[PADI((FN - k) & (FN - 1))]; f32x2 H;
            if (o == 0) H = (f32x2){(g.x + gm.x) * i0, (g.y - gm.y) * i0};
            else        H = (f32x2){(g.y + gm.y) * i1, (gm.x - g.x) * i1};
            const f32x2 p = cmul(ZB[PADI(k)], H); ZB[PADI(k)] = (f32x2){p.x, -p.y}; }
        __syncthreads();
        const int ch = o * 512 + c; const float w0 = cw[ch], w1 = cw[NHY + ch], w2 = cw[2 * NHY + ch], bb = cbias[ch];
        const float sk = inp(I_HYSKIP)[((size_t)l * 2 + o) * HYW + c];
        HyTaps gt[8][2];
#pragma unroll
        for (int q = 0; q < 8; ++q) { const int t = tid + NTHR * q; gt[q][0] = hy_taps(HYT + (size_t)ch * M + CTXL, t, SEQ); gt[q][1] = hy_taps(HYT + (size_t)ch * M + RB + CTXL, t, SEQ); }
        fft8192<false, true>(ZB, tid);
#pragma unroll
        for (int q = 0; q < 8; ++q) { const int t = tid + NTHR * q; const f32x2 y = ZB[PADI(t)];
            const float zc0 = y.x * (1.0f / FN), zc1 = -y.y * (1.0f / FN);
            const float g0 = hy_apply(gt[q][0], t, SEQ, w0, w1, w2, bb), g1 = hy_apply(gt[q][1], t, SEQ, w0, w1, w2, bb);
            z[q][0] = g0 * (zc0 + sk * z[q][0]); z[q][1] = g1 * (zc1 + sk * z[q][1]); }
        __syncthreads();
        if (o == 0) {
#pragma unroll
            for (int q = 0; q < 8; ++q) { const int t = tid + NTHR * q; ZB[PADI(t)] = (f32x2){z[q][0], z[q][1]}; }
            __syncthreads();
        }
    }
    bf16* YHT = (bf16*)(wsb() + WS_YHT) + (size_t)c * M;
#pragma unroll
    for (int q = 0; q < 8; ++q) { const int t = tid + NTHR * q; YHT[CTXL + t] = f2bf(z[q][0]); YHT[RB + CTXL + t] = f2bf(z[q][1]); }
    __syncthreads();
}
__device__ __forceinline__ void hyena_ctx_unit(const Args& a, int l, int c, LAS unsigned char* lds, int tid, int wave, int lane) {
    asm volatile("" : "+v"(tid), "+v"(lane));
    LAS float* hf = (LAS float*)lds; LAS float* zz = hf + 1024; LAS float* red = zz + 512;
    const float* F = (const float*)(wsb() + WS_FILT) + (size_t)l * 2048 * RB + (size_t)c * RB + SEQ;
    const float dec = hy_decay(c);
    float s0 = 0.f, s1 = 0.f;
    if (tid < CTXL) { const int t = tid;
        const float dm = fast_exp(-((float)t / 255.0f) * dec);
        const float a0 = F[t] * dm, a1 = F[(size_t)512 * RB + t] * dm, a2 = F[(size_t)1024 * RB + t] * dm, a3 = F[(size_t)1536 * RB + t] * dm;
        hf[256 + t] = a0; hf[512 + 256 + t] = a1; s0 += fabsf(a0); s1 += fabsf(a1);
        if (t >= 1) { hf[256 - t] = a2; hf[512 + 256 - t] = a3; s0 += fabsf(a2); s1 += fabsf(a3); }
        if (t == 0) { hf[0] = 0.f; hf[512] = 0.f; } }
    const float S0 = block_sum(s0, red, tid, wave, lane); const float S1 = block_sum(s1, red, tid, wave, lane);
    const bf16* HYT = (const bf16*)(wsb() + WS_HYT);
    const float* cw = inp(I_HYCW) + (size_t)l * 3 * NHY; const float* cbias = inp(I_HYCB) + (size_t)l * NHY;
    const int b = tid >> 8, t = tid & 255;
    float z;
    {   const int ch = 1024 + c; z = hy_conv3(HYT + (size_t)ch * M + b * RB, t, CTXL, cw[ch], cw[NHY + ch], cw[2 * NHY + ch], cbias[ch]); }
    __syncthreads();
    for (int o = 0; o < 2; ++o) {
        zz[b * 256 + t] = z; __syncthreads();
        const LAS float* h = hf + o * 512 + 256; const LAS float* zb = zz + b * 256; float acc = 0.f;
#pragma unroll 8
        for (int s = 0; s < CTXL; ++s) acc += h[t - s] * zb[s];
        acc *= 1.0f / (o == 0 ? S0 : S1);
        const int ch = o * 512 + c; const float g = hy_conv3(HYT + (size_t)ch * M + b * RB, t, CTXL, cw[ch], cw[NHY + ch], cw[2 * NHY + ch], cbias[ch]);
        z = g * (acc + inp(I_HYSKIP)[((size_t)l * 2 + o) * HYW + c] * z);
        __syncthreads();
    }
    ((bf16*)(wsb() + WS_YHT))[(size_t)c * M + b * RB + t] = f2bf(z);
    __syncthreads();
}

__device__ __forceinline__ int lru_ord(int d, int ch) { return d == 0 ? ch : (ch < 2 ? 1 - ch : 2 + (33 - ch)); }
template <int PASS>
__device__ __forceinline__ void lru_unit(const Args& a, int l, int u, LAS unsigned char* lds, int tid, int wave, int lane) {
    asm volatile("" : "+v"(tid), "+v"(lane));
    const int b = u / (8 * LRU_NCH), hd = (u / LRU_NCH) % 8, ch = u % LRU_NCH;
    LAS float* AB = (LAS float*)lds; LAS float* BB = AB + 128 * 64; LAS bf16* XR = (LAS bf16*)(BB + 128 * 64);
    LAS bf16* WT = XR + 128 * 72; LAS float* SEG = (LAS float*)(WT + 4 * 64 * 72); LAS float* CIN = SEG + 8 * 64 * 2;
    const bf16* U = (const bf16*)(wsb() + WS_U);
    const int p0 = ch * LRU_CH; const int reg_lo = ch < 2 ? 0 : CTXL, reg_hi = ch < 2 ? CTXL : RB;
    const size_t rowbase = (size_t)b * RB;
    const int sch = tid & 63, seg = tid >> 6;
    const int cg = tid & 7; const float* cw = inp(I_LCW) + (size_t)l * 4 * 512 + hd * 64 + 8 * cg; const float* cbv = inp(I_LCB) + (size_t)l * 512 + hd * 64 + 8 * cg;
    f32x4 wv[4][2], bias[2]; u32x4 raw[2][4]; f32x4 va[2][2], vx[2][2];
#pragma unroll
    for (int jt = 0; jt < 2; ++jt)
#pragma unroll
        for (int j = 0; j < 4; ++j) { const int p = p0 + (tid >> 3) + 64 * jt, pp = p + j - 2; const bool ok = (pp >= reg_lo && pp < reg_hi);
            raw[jt][j] = *(const u32x4*)(U + (rowbase + (ok ? pp : p)) * NREST + UC_REC + hd * 64 + 8 * cg); }
#pragma unroll
    for (int j = 0; j < 4; ++j) { wv[j][0] = *(const f32x4*)(cw + j * 512); wv[j][1] = *(const f32x4*)(cw + j * 512 + 4); }
    bias[0] = *(const f32x4*)cbv; bias[1] = *(const f32x4*)(cbv + 4);
#pragma unroll
    for (int d = 0; d < 2; ++d) { const float* wa = inp(I_LWA) + ((((size_t)l * 2 + d) * 8 + hd) * 64) * 64; const float* wx = inp(I_LWX) + ((((size_t)l * 2 + d) * 8 + hd) * 64) * 64;
#pragma unroll
        for (int j = 0; j < 2; ++j) { va[d][j] = ((const f32x4*)wa)[tid + NTHR * j]; vx[d][j] = ((const f32x4*)wx)[tid + NTHR * j]; } }
    bf16 gt[16];
    if (PASS == 2) {
#pragma unroll
        for (int i = 0; i < 16; ++i) gt[i] = U[(rowbase + p0 + 16 * seg + i) * NREST + UC_GATE + hd * 64 + sch];
        if (tid < 128) { const int d = tid >> 6, c64 = tid & 63; const int ord = lru_ord(d, ch); const f32x2* agg = (const f32x2*)(wsb() + WS_LRUAGG) + (((size_t)b * 2 + d) * LRU_NCH * 512 + hd * 64 + c64);
            f32x2 ab[LRU_NCH];
#pragma unroll
            for (int q = 0; q < LRU_NCH; ++q) ab[q] = agg[(size_t)q * 512];
            float h = 0.f;
#pragma unroll
            for (int q = 0; q < LRU_NCH; ++q) { const float hn = ab[q].x * h + ab[q].y; h = (q < ord) ? hn : h; }
            CIN[d * 64 + c64] = h; }
    }
#pragma unroll
    for (int jt = 0; jt < 2; ++jt) { const int t = (tid >> 3) + 64 * jt, p = p0 + t;
        f32x4 a0 = bias[0], a1 = bias[1];
#pragma unroll
        for (int j = 0; j < 4; ++j) { const int pp = p + j - 2; const bool ok = (pp >= reg_lo && pp < reg_hi); const u32x4 rw = ok ? raw[jt][j] : (u32x4){0u, 0u, 0u, 0u};
            const f32x4 lo = {__uint_as_float(rw.x << 16), __uint_as_float(rw.x & 0xffff0000u), __uint_as_float(rw.y << 16), __uint_as_float(rw.y & 0xffff0000u)};
            const f32x4 hi4 = {__uint_as_float(rw.z << 16), __uint_as_float(rw.z & 0xffff0000u), __uint_as_float(rw.w << 16), __uint_as_float(rw.w & 0xffff0000u)};
            a0 += wv[j][0] * lo; a1 += wv[j][1] * hi4; }
        u32x4 pk; pk.x = pk_bf16(a0[0], a0[1]); pk.y = pk_bf16(a0[2], a0[3]); pk.z = pk_bf16(a1[0], a1[1]); pk.w = pk_bf16(a1[2], a1[3]);
        *(LAS u32x4*)(XR + t * 72 + 8 * cg) = pk; }
#pragma unroll
    for (int d = 0; d < 2; ++d)
#pragma unroll
        for (int j = 0; j < 2; ++j) { const int idx = tid + NTHR * j, k = idx >> 4, n4 = (idx & 15) * 4;
#pragma unroll
            for (int q = 0; q < 4; ++q) { WT[(d * 2 + 0) * 64 * 72 + (n4 + q) * 72 + k] = f2bf(va[d][j][q]); WT[(d * 2 + 1) * 64 * 72 + (n4 + q) * 72 + k] = f2bf(vx[d][j][q]); } }
    float hsum[16];
#pragma unroll
    for (int i = 0; i < 16; ++i) hsum[i] = 0.f;
    for (int d = 0; d < 2; ++d) {
        __syncthreads();
        {   const int fr = lane & 15, fq = lane >> 4;
            bf16x8 af[2];
#pragma unroll
            for (int ks = 0; ks < 2; ++ks) af[ks] = *(const LAS bf16x8*)(XR + (16 * wave + fr) * 72 + 8 * fq + 32 * ks);
            const float* bav = inp(I_LBA) + ((size_t)l * 2 + d) * 512 + hd * 64; const float* bxv = inp(I_LBX) + ((size_t)l * 2 + d) * 512 + hd * 64;
            const float* lamv = inp(I_LLAM) + ((size_t)l * 2 + d) * 512 + hd * 64;
            float bav4[4], bxv4[4], lam4[4];
#pragma unroll
            for (int nt = 0; nt < 4; ++nt) { bav4[nt] = bav[16 * nt + fr]; bxv4[nt] = bxv[16 * nt + fr]; lam4[nt] = lamv[16 * nt + fr]; }
            const LAS bf16* Wd = WT + d * 2 * 64 * 72;
#pragma unroll
            for (int nt = 0; nt < 4; ++nt) {
                f32x4 ar = {0.f, 0.f, 0.f, 0.f}, ai = ar;
#pragma unroll
                for (int ks = 0; ks < 2; ++ks) { const bf16x8 bfa = *(const LAS bf16x8*)(Wd + (16 * nt + fr) * 72 + 8 * fq + 32 * ks); const bf16x8 bfx = *(const LAS bf16x8*)(Wd + 64 * 72 + (16 * nt + fr) * 72 + 8 * fq + 32 * ks);
                    ar = __builtin_amdgcn_mfma_f32_16x16x32_bf16(af[ks], bfa, ar, 0, 0, 0); ai = __builtin_amdgcn_mfma_f32_16x16x32_bf16(af[ks], bfx, ai, 0, 0, 0); }
                const int cc = 16 * nt + fr; const float ba = bav4[nt], bx = bxv4[nt], lam = lam4[nt];
                const float ex = fast_exp(-lam); const float sp = (ex < 0.06f) ? ex * (1.f - ex * (0.5f - ex * (0.33333334f - 0.25f * ex))) : __logf(1.f + ex);
#pragma unroll
                for (int g = 0; g < 4; ++g) { const int t = 16 * wave + 4 * fq + g;
                    const float r = sigm(ar[g] + ba), ig = sigm(ai[g] + bx);
                    const float la = -8.0f * r * sp, x2 = 2.f * la;
                    const float av = fast_exp(la);
                    const float em = (x2 > -0.25f) ? -x2 * (1.f + x2 * (0.5f + x2 * (0.16666667f + x2 * (0.041666668f + x2 * 0.0083333333f)))) : 1.f - av * av;
                    AB[t * 64 + cc] = av; BB[t * 64 + cc] = sqrtf(fmaxf(em, 0.f)) * (ig * bf2f(XR[t * 72 + cc])); } }
        }
        __syncthreads();
        float A = 1.f, Bv = 0.f;
#pragma unroll
        for (int i = 0; i < 16; ++i) { const int t = d == 0 ? 16 * seg + i : 16 * seg + 15 - i; const float av = AB[t * 64 + sch], bv = BB[t * 64 + sch]; Bv = av * Bv + bv; A *= av; }
        SEG[(seg * 64 + sch) * 2] = A; SEG[(seg * 64 + sch) * 2 + 1] = Bv;
        __syncthreads();
        if (PASS == 1) {
            if (tid < 64) { float CA = 1.f, CB = 0.f;
#pragma unroll
                for (int s = 0; s < 8; ++s) { const int sg = d == 0 ? s : 7 - s; const float sa = SEG[(sg * 64 + tid) * 2], sb = SEG[(sg * 64 + tid) * 2 + 1]; CB = sa * CB + sb; CA *= sa; }
                f32x2* agg = (f32x2*)(wsb() + WS_LRUAGG) + ((((size_t)b * 2 + d) * LRU_NCH + lru_ord(d, ch)) * 512 + hd * 64 + tid);
                *agg = (f32x2){CA, CB}; }
        } else {
            float h = CIN[d * 64 + sch];
            for (int s = 0; s < 8; ++s) { const int sg = d == 0 ? s : 7 - s; const bool before = d == 0 ? (sg < seg) : (sg > seg);
                if (before) h = SEG[(sg * 64 + sch) * 2] * h + SEG[(sg * 64 + sch) * 2 + 1]; }
#pragma unroll
            for (int i = 0; i < 16; ++i) { if (d == 0) { const int t = 16 * seg + i; h = AB[t * 64 + sch] * h + BB[t * 64 + sch]; hsum[i] += h; }
                                           else { const int t = 16 * seg + 15 - i; h = AB[t * 64 + sch] * h + BB[t * 64 + sch]; hsum[15 - i] += h; } }
        }
    }
    if (PASS == 2) {
        bf16* MIX = (bf16*)(wsb() + WS_MIX);
#pragma unroll
        for (int i = 0; i < 16; ++i) { const size_t row = rowbase + p0 + 16 * seg + i; const float y = hsum[i] * gelu_tanh(bf2f(gt[i]));
#if FP8_OUT
            ((unsigned char*)MIX)[row * DM + 512 + hd * 64 + sch] = (unsigned char)(cvt2_fp8(y * MIX8_SCALE, 0.f, 0, false) & 0xff); }
#else
            MIX[row * DM + 512 + hd * 64 + sch] = f2bf(y); }
#endif
    }
    __syncthreads();
}

__device__ __forceinline__ void p_mix3(const Args& a, int l, LAS unsigned char* lds, int G, int bid, int tid, int wave, int lane, int sub = 7) {
    asm volatile("" : "+v"(tid), "+v"(lane));
    bf16* MIX = (bf16*)(wsb() + WS_MIX);
    if (sub & 1) {
        const float* O0 = (const float*)(wsb() + WS_OATT); const float* O1 = O0 + (size_t)M * 1024;
        const float lam = ((const float*)(wsb() + WS_LAMS))[l]; const float lam_init = 0.8f - 0.6f * fast_exp(-0.3f * (float)l);
        const f32x4 gn = ((const f32x4*)(inp(I_SUBLN) + (size_t)l * 256))[lane];
        for (int row = bid * NWAVES + wave; row < M; row += G * NWAVES) {
            if (l == NLAYER - 1 && (row < CTXL || (row >= RB && row < RB + CTXL))) continue;
            f32x4 x0[4], x1[4];
#pragma unroll
            for (int h = 0; h < 4; ++h) { x0[h] = __builtin_nontemporal_load((const f32x4*)(O0 + (size_t)row * 1024 + h * 256) + lane); x1[h] = __builtin_nontemporal_load((const f32x4*)(O1 + (size_t)row * 1024 + h * 256) + lane); }
#pragma unroll
            for (int h = 0; h < 4; ++h) { const f32x4 o = x0[h] - x1[h] * lam; const float ss = wave_sum((o[0] * o[0] + o[1] * o[1]) + (o[2] * o[2] + o[3] * o[3]));
                const float sc = (1.f / sqrtf(ss * (1.f / 256.f) + LN_EPS)) * (1.f - lam_init);
                const f32x4 y = o * gn * sc;
#if FP8_OUT
                int w8 = 0; w8 = cvt2_fp8(y[0] * MIX8_SCALE, y[1] * MIX8_SCALE, w8, false); w8 = cvt2_fp8(y[2] * MIX8_SCALE, y[3] * MIX8_SCALE, w8, true);
                ((unsigned*)((unsigned char*)MIX + (size_t)row * DM + 1024 + h * 256))[lane] = (unsigned)w8; } }
#else
                u32x2 w; w.x = pk_bf16(y[0], y[1]); w.y = pk_bf16(y[2], y[3]);
                ((u32x2*)(MIX + (size_t)row * DM + 1024 + h * 256))[lane] = w; } }
#endif
    }
    if (sub & 2) {
        const bf16* YHT = (const bf16*)(wsb() + WS_YHT); LAS bf16* T = (LAS bf16*)lds;
        for (int u = G - 1 - bid; u < M / 64; u += G) { const int r0 = u * 64;
            __syncthreads();
            for (int i = tid; i < 512 * 8; i += NTHR) { const int c = i >> 3, k = i & 7; const u32x4 v = __builtin_nontemporal_load((const u32x4*)(YHT + (size_t)c * M + r0 + 8 * k));
                LAS unsigned* d = (LAS unsigned*)(T + c * 66 + 8 * k); d[0] = v.x; d[1] = v.y; d[2] = v.z; d[3] = v.w; }
            __syncthreads();
            for (int i = tid; i < 64 * 64; i += NTHR) { const int t = i >> 6, c8 = (i & 63) * 8; unsigned w[4];
#pragma unroll
                for (int j = 0; j < 4; ++j) w[j] = (unsigned)T[(c8 + 2 * j) * 66 + t] | ((unsigned)T[(c8 + 2 * j + 1) * 66 + t] << 16);
#if FP8_OUT
                int wa = 0, wb = 0;
                wa = cvt2_fp8(__uint_as_float(w[0] << 16) * MIX8_SCALE, __uint_as_float(w[0] & 0xffff0000u) * MIX8_SCALE, wa, false); wa = cvt2_fp8(__uint_as_float(w[1] << 16) * MIX8_SCALE, __uint_as_float(w[1] & 0xffff0000u) * MIX8_SCALE, wa, true);
                wb = cvt2_fp8(__uint_as_float(w[2] << 16) * MIX8_SCALE, __uint_as_float(w[2] & 0xffff0000u) * MIX8_SCALE, wb, false); wb = cvt2_fp8(__uint_as_float(w[3] << 16) * MIX8_SCALE, __uint_as_float(w[3] & 0xffff0000u) * MIX8_SCALE, wb, true);
                *(u32x2*)((unsigned char*)MIX + (size_t)(r0 + t) * DM + c8) = (u32x2){(unsigned)wa, (unsigned)wb}; }
#else
                *(u32x4*)(MIX + (size_t)(r0 + t) * DM + c8) = (u32x4){w[0], w[1], w[2], w[3]}; }
#endif
        }
        __syncthreads();
    }
}

__device__ __forceinline__ void wave_sum2(float& a0, float& a1) {
#define WS2_STEP(O) { const float t0 = xor_get<O>(a0), t1 = xor_get<O>(a1); a0 += t0; a1 += t1; }
    WS2_STEP(1) WS2_STEP(2) WS2_STEP(4) WS2_STEP(8) WS2_STEP(16)
#undef WS2_STEP
    a0 = half_sum(a0); a1 = half_sum(a1);
}
__device__ __forceinline__ void p_ln2(const Args& a, int l, LAS unsigned char* lds, int G, int bid, int tid, int wave, int lane, int sub = 7) {
    asm volatile("" : "+v"(tid), "+v"(lane));
    const float* mod = (const float*)(wsb() + WS_MOD) + (size_t)l * 3 * (6 * DM);
    const bf16* Rb = (const bf16*)(wsb() + WS_RBUF); bf16* XA = (bf16*)(wsb() + WS_XA); unsigned char* H2 = wsb() + WS_H2;
    bf16* Hhi = (bf16*)(wsb() + WS_H2F); bf16* Hlo = Hhi + (size_t)M * DM;
    const float* lg = inp(I_LNG) + ((size_t)l * 2 + 0) * DM; const float* lb = inp(I_LNB) + ((size_t)l * 2 + 0) * DM;
    const bf16* RWT = (const bf16*)(wsb() + WS_RWT) + (size_t)l * 2 * NEXP * DM; const float* rbias = inp(I_RB) + (size_t)l * NEXP;
    unsigned* cnt = (unsigned*)(wsb() + WS_CTL) + CW_CNT + 64 * l * CNT_ST;
    int* ltok = (int*)(wsb() + WS_LIST); int* ldst = ltok + (size_t)NEXP * LCAP; int* lw = ldst + (size_t)NEXP * LCAP;
    LAS float* red = (LAS float*)lds;
    LAS int* sel_e = (LAS int*)(lds + 69632);
    LAS float* sel_w = (LAS float*)(lds + 69632 + 1280);
    LAS int* sel_p = (LAS int*)(lds + 69632 + 2560);
    LAS int* hist = (LAS int*)(lds + 69632 + 3840);
    LAS int* gbase = (LAS int*)(lds + 69632 + 4096);
    const int last = (l == NLAYER - 1);
    const int NR = last ? 32 : 34;
#define LN2_GROW(uu_, r0_, i_) ((i_) < 32 ? (r0_) + (i_) : ((2 * (uu_) + (i_) - 32) < CTXL ? (2 * (uu_) + (i_) - 32) : RB + (2 * (uu_) + (i_) - 32) - CTXL))
    LAS f32x4* P_lg = (LAS f32x4*)(lds + 75776); LAS f32x4* P_lb = P_lg + 512; LAS f32x4* P_sh = P_lb + 512; LAS f32x4* P_sc = P_sh + 3 * 512;
    {   const int i = tid; f32x4 t8[8];
        t8[0] = ((const f32x4*)lg)[i]; t8[1] = ((const f32x4*)lb)[i];
#pragma unroll
        for (int mi = 0; mi < 3; ++mi) { t8[2 + mi] = ((const f32x4*)(mod + (size_t)mi * (6 * DM) + 3 * DM))[i]; t8[5 + mi] = ((const f32x4*)(mod + (size_t)mi * (6 * DM) + 4 * DM))[i]; }
        P_lg[i] = t8[0]; P_lb[i] = t8[1];
#pragma unroll
        for (int mi = 0; mi < 3; ++mi) { P_sh[mi * 512 + i] = t8[2 + mi]; P_sc[mi * 512 + i] = t8[5 + mi]; } }
    __syncthreads();
    for (int uu = bid; uu < NB * SEQ / 32; uu += G) { const int u = uu + 8 + (uu >= 128 ? 8 : 0); const int r0 = u * 32;
#ifndef PROBE_DUPA
#define PROBE_DUPA 1
#endif
        if (sub & 1) for (int rp = 0; rp < ((wave == 0 && !last) ? 3 : 2); ++rp) { const int ra = (rp < 2) ? r0 + wave * 4 + 2 * rp : LN2_GROW(uu, r0, 32); const int mi = row_mod(ra);
            f32x4 v[2][8]; float s[2] = {0.f, 0.f}, q[2];
#pragma unroll
            for (int t = 0; t < 2; ++t)
#pragma unroll
                for (int jj = 0; jj < 4; ++jj) { const u32x4 w = __builtin_nontemporal_load((const u32x4*)(Rb + (size_t)(ra + t) * DM) + lane + 64 * jj);
                    v[t][2 * jj] = (f32x4){__uint_as_float(w.x << 16), __uint_as_float(w.x & 0xffff0000u), __uint_as_float(w.y << 16), __uint_as_float(w.y & 0xffff0000u)};
                    v[t][2 * jj + 1] = (f32x4){__uint_as_float(w.z << 16), __uint_as_float(w.z & 0xffff0000u), __uint_as_float(w.w << 16), __uint_as_float(w.w & 0xffff0000u)}; }
#pragma unroll
            for (int t = 0; t < 2; ++t)
#pragma unroll
                for (int j = 0; j < 8; ++j) s[t] += (v[t][j][0] + v[t][j][1]) + (v[t][j][2] + v[t][j][3]);
            wave_sum2(s[0], s[1]);
#pragma unroll
            for (int t = 0; t < 2; ++t) { const float mean = s[t] * (1.f / DM); q[t] = 0.f;
#pragma unroll
                for (int j = 0; j < 8; ++j) { v[t][j] = v[t][j] - mean; q[t] += (v[t][j][0] * v[t][j][0] + v[t][j][1] * v[t][j][1]) + (v[t][j][2] * v[t][j][2] + v[t][j][3] * v[t][j][3]); } }
            wave_sum2(q[0], q[1]);
#pragma unroll
            for (int t = 0; t < 2; ++t) { const float rstd = 1.f / sqrtf(q[t] * (1.f / DM) + LN_EPS); s[t] = 0.f;
#pragma unroll
                for (int jj = 0; jj < 4; ++jj) {
#pragma unroll
                    for (int h = 0; h < 2; ++h) { const int j = 2 * jj + h, ci = 2 * (lane + 64 * jj) + h; v[t][j] = v[t][j] * rstd * P_lg[ci] + P_lb[ci]; s[t] += (v[t][j][0] + v[t][j][1]) + (v[t][j][2] + v[t][j][3]); }
                    ((u32x4*)(XA + (size_t)(ra + t) * DM))[lane + 64 * jj] = (u32x4){pk_bf16(v[t][2 * jj][0], v[t][2 * jj][1]), pk_bf16(v[t][2 * jj][2], v[t][2 * jj][3]), pk_bf16(v[t][2 * jj + 1][0], v[t][2 * jj + 1][1]), pk_bf16(v[t][2 * jj + 1][2], v[t][2 * jj + 1][3])}; } }
            wave_sum2(s[0], s[1]);
#pragma unroll
            for (int t = 0; t < 2; ++t) { const float mean = s[t] * (1.f / DM); q[t] = 0.f;
#pragma unroll
                for (int j = 0; j < 8; ++j) { v[t][j] = v[t][j] - mean; q[t] += (v[t][j][0] * v[t][j][0] + v[t][j][1] * v[t][j][1]) + (v[t][j][2] * v[t][j][2] + v[t][j][3] * v[t][j][3]); } }
            wave_sum2(q[0], q[1]);
#pragma unroll
            for (int t = 0; t < 2; ++t) { const float rstd = 1.f / sqrtf(q[t] * (1.f / DM) + LN_EPS); const size_t ro = (size_t)(ra + t) * DM;
#pragma unroll
                for (int jj = 0; jj < 4; ++jj) { unsigned hh[4], ll[4]; int w8[2];
#pragma unroll
                    for (int h = 0; h < 2; ++h) { const int ci = 2 * (lane + 64 * jj) + h; const f32x4 sh = P_sh[mi * 512 + ci], sc = P_sc[mi * 512 + ci];
                        const f32x4 o = v[t][2 * jj + h] * rstd * (sc + 1.f) + sh;
                        const unsigned h01 = pk_bf16(o[0], o[1]), h23 = pk_bf16(o[2], o[3]);
                        const float l0 = o[0] - __uint_as_float(h01 << 16), l1 = o[1] - __uint_as_float(h01 & 0xffff0000u), l2 = o[2] - __uint_as_float(h23 << 16), l3 = o[3] - __uint_as_float(h23 & 0xffff0000u);
                        hh[2 * h] = h01; hh[2 * h + 1] = h23; ll[2 * h] = pk_bf16(l0, l1); ll[2 * h + 1] = pk_bf16(l2, l3);
                        int w = 0; w = cvt2_fp8(o[0], o[1], w, false); w = cvt2_fp8(o[2], o[3], w, true); w8[h] = w; }
                    ((u32x4*)(Hhi + ro))[lane + 64 * jj] = (u32x4){hh[0], hh[1], hh[2], hh[3]}; ((u32x4*)(Hlo + ro))[lane + 64 * jj] = (u32x4){ll[0], ll[1], ll[2], ll[3]};
                    ((u32x2*)(H2 + ro))[lane + 64 * jj] = (u32x2){(unsigned)w8[0], (unsigned)w8[1]}; } } }
        if (tid < 64) hist[tid] = 0;
        VM_WAIT(); __syncthreads();
        if (sub & 2) {   const int fr = lane & 15, fq = lane >> 4;
            f32x4 c[3][4];
#pragma unroll
            for (int mt = 0; mt < 3; ++mt)
#pragma unroll
                for (int nt = 0; nt < 4; ++nt) c[mt][nt] = (f32x4){0.f, 0.f, 0.f, 0.f};
            const int r2 = LN2_GROW(uu, r0, 32 + (fr & 1));
            const size_t ao = (size_t)(r0 + fr) * DM + wave * 256 + 8 * fq, ao2 = (size_t)r2 * DM + wave * 256 + 8 * fq, bo = (size_t)fr * DM + wave * 256 + 8 * fq;
#pragma unroll 2
            for (int ks = 0; ks < 8; ++ks) {
                bf16x8 ah[3], al[3], bh[4], bl[4];
#pragma unroll
                for (int mt = 0; mt < 2; ++mt) { ah[mt] = *(const bf16x8*)(Hhi + ao + (size_t)(16 * mt) * DM + 32 * ks); al[mt] = *(const bf16x8*)(Hlo + ao + (size_t)(16 * mt) * DM + 32 * ks); }
                ah[2] = *(const bf16x8*)(Hhi + ao2 + 32 * ks); al[2] = *(const bf16x8*)(Hlo + ao2 + 32 * ks);
#pragma unroll
                for (int nt = 0; nt < 4; ++nt) { bh[nt] = *(const bf16x8*)(RWT + bo + (size_t)(16 * nt) * DM + 32 * ks); bl[nt] = *(const bf16x8*)(RWT + (size_t)NEXP * DM + bo + (size_t)(16 * nt) * DM + 32 * ks); }
#pragma unroll
                for (int mt = 0; mt < 3; ++mt) { if (mt == 2 && last) continue;
#pragma unroll
                    for (int nt = 0; nt < 4; ++nt) { c[mt][nt] = __builtin_amdgcn_mfma_f32_16x16x32_bf16(al[mt], bh[nt], c[mt][nt], 0, 0, 0); c[mt][nt] = __builtin_amdgcn_mfma_f32_16x16x32_bf16(ah[mt], bl[nt], c[mt][nt], 0, 0, 0);
                        c[mt][nt] = __builtin_amdgcn_mfma_f32_16x16x32_bf16(ah[mt], bh[nt], c[mt][nt], 0, 0, 0); } } }
#pragma unroll
            for (int mt = 0; mt < 3; ++mt)
#pragma unroll
                for (int nt = 0; nt < 4; ++nt)
#pragma unroll
                    for (int g = 0; g < 4; ++g) { const int row = (mt < 2) ? 16 * mt + 4 * fq + g : 32 + g;
                        if (mt < 2 || (fq == 0 && g < 2 && !last)) red[(wave * 34 + row) * 64 + 16 * nt + fr] = c[mt][nt][g]; } }
        __syncthreads();
        if (!(sub & 4)) continue;
#define LN2_TOPK_ROW(row_) do { const int row = (row_); float lgt = 0.f; \
            _Pragma("unroll") for (int w = 0; w < 8; ++w) lgt += red[(w * 34 + row) * 64 + lane]; \
            const float score = 1.f / (1.f + __expf(-lgt)); float key = score + rbias[lane]; float ssum = 0.f; int my_slot = -1; \
            _Pragma("unroll") for (int k = 0; k < TOPK; ++k) { const float mx = wave_max(key); const unsigned long long bal = __ballot(key == mx); const int win = bal ? __ffsll((long long)bal) - 1 : k;        \
                const float ws_ = __shfl(score, win); ssum += ws_; if (lane == win) { my_slot = k; key = -3.0e38f; } } \
            if (my_slot >= 0) { sel_e[row * 8 + my_slot] = lane; sel_w[row * 8 + my_slot] = score / ssum * ROUTED_SCALE; sel_p[row * 8 + my_slot] = __hip_atomic_fetch_add(&hist[lane], 1, __ATOMIC_RELAXED, __HIP_MEMORY_SCOPE_WORKGROUP); } } while (0)
        LN2_TOPK_ROW(wave * 4 + 0); LN2_TOPK_ROW(wave * 4 + 1); LN2_TOPK_ROW(wave * 4 + 2); LN2_TOPK_ROW(wave * 4 + 3);
        if (wave < 2 && !last) LN2_TOPK_ROW(32 + wave);
#undef LN2_TOPK_ROW
        __syncthreads();
        if (tid < 64) gbase[tid] = (int)__hip_atomic_fetch_add(cnt + tid * CNT_ST, (unsigned)hist[tid], RLX_AGENT);
        __syncthreads();
        if (tid < NR * 8) { const int row = tid >> 3, k = tid & 7; const int e = sel_e[tid]; const int pos = gbase[e] + sel_p[tid]; const int tok = LN2_GROW(uu, r0, row);
            ltok[(size_t)e * LCAP + pos] = tok; ldst[(size_t)e * LCAP + pos] = tok * 9 + k; lw[(size_t)e * LCAP + pos] = __float_as_int(sel_w[tid]); }
        __syncthreads();
    }
}

#ifndef FFN_GRP
#define FFN_GRP 4
#endif
__device__ __forceinline__ void p_ffnln(const Args& a, int l, LAS unsigned char* lds, int G, int bid, int wave, int lane) {
    asm volatile("" : "+v"(lane));
    const float* mod = (const float*)(wsb() + WS_MOD) + (size_t)l * 3 * (6 * DM);
    const bf16* XA = (const bf16*)(wsb() + WS_XA); const bf16* YG = (const bf16*)(wsb() + WS_YG);
    const float* lg = inp(I_LNG) + ((size_t)l * 2 + 1) * DM; const float* lb = inp(I_LNB) + ((size_t)l * 2 + 1) * DM;
    LAS f32x4* P_lg = (LAS f32x4*)lds; LAS f32x4* P_lb = P_lg + 512; LAS f32x4* P_g2 = P_lb + 512; LAS f32x4* P_sh = P_g2 + 3 * 512; LAS f32x4* P_sc = P_sh + 3 * 512;
    {   const int i = wave * 64 + lane; f32x4 t11[11]; const int nl = (l + 1 < NLAYER) ? 3 : 0;
        t11[0] = ((const f32x4*)lg)[i]; t11[1] = ((const f32x4*)lb)[i];
#pragma unroll
        for (int mi = 0; mi < 3; ++mi) { t11[2 + mi] = ((const f32x4*)(mod + (size_t)mi * (6 * DM) + 5 * DM))[i];
            t11[5 + mi] = ((const f32x4*)(mod + (size_t)(nl + mi) * (6 * DM)))[i]; t11[8 + mi] = ((const f32x4*)(mod + (size_t)(nl + mi) * (6 * DM) + DM))[i]; }
        P_lg[i] = t11[0]; P_lb[i] = t11[1];
#pragma unroll
        for (int mi = 0; mi < 3; ++mi) { P_g2[mi * 512 + i] = t11[2 + mi]; P_sh[mi * 512 + i] = t11[5 + mi]; P_sc[mi * 512 + i] = t11[8 + mi]; } }
    __syncthreads();
    for (int r = bid * NWAVES + wave; r < M; r += G * NWAVES) {
        const int b = r >= RB ? 1 : 0, p = r - b * RB;
        float* dst = nullptr; bf16* dstb = (bf16*)(wsb() + WS_XB) + (size_t)r * DM;
        if (l == NLAYER - 1) { if (p < CTXL) continue; dst = outb() + ((size_t)b * SEQ + (p - CTXL)) * DM; }
        const int mi = row_mod(r);
        f32x4 v[8]; float s = 0.f;
        const bf16* yrow = YG + (size_t)r * 9 * DM;
#pragma unroll
        for (int jp = 0; jp < 4 / FFN_GRP; ++jp) {
            u32x4 w[FFN_GRP][9], xw[FFN_GRP];
#pragma unroll
            for (int g = 0; g < FFN_GRP; ++g) { const int jj = jp * FFN_GRP + g;
#pragma unroll
#if YG_F8
                for (int k = 0; k < 9; ++k) { const u32x2 q8 = __builtin_nontemporal_load((const u32x2*)((const unsigned char*)YG + ((size_t)r * 9 + k) * DM) + lane + 64 * jj); w[g][k] = (u32x4){q8.x, q8.y, 0u, 0u}; }
#else
                for (int k = 0; k < 9; ++k) w[g][k] = __builtin_nontemporal_load((const u32x4*)(yrow + (size_t)k * DM) + lane + 64 * jj);
#endif
                xw[g] = __builtin_nontemporal_load((const u32x4*)(XA + (size_t)r * DM) + lane + 64 * jj); }
#pragma unroll
            for (int g = 0; g < FFN_GRP; ++g) { const int jj = jp * FFN_GRP + g; f32x4 f0 = {0.f, 0.f, 0.f, 0.f}, f1 = f0;
#pragma unroll
                for (int k = 0; k < 9; ++k) { const u32x4 ww = w[g][k];
#if YG_F8
                    { const auto a0 = __builtin_amdgcn_cvt_pk_f32_fp8((int)ww.x, false), a1 = __builtin_amdgcn_cvt_pk_f32_fp8((int)ww.x, true), b0 = __builtin_amdgcn_cvt_pk_f32_fp8((int)ww.y, false), b1 = __builtin_amdgcn_cvt_pk_f32_fp8((int)ww.y, true);
                      f0[0] += a0[0]; f0[1] += a0[1]; f0[2] += a1[0]; f0[3] += a1[1]; f1[0] += b0[0]; f1[1] += b0[1]; f1[2] += b1[0]; f1[3] += b1[1]; continue; }
#endif
                    f0[0] += __uint_as_float(ww.x << 16); f0[1] += __uint_as_float(ww.x & 0xffff0000u); f0[2] += __uint_as_float(ww.y << 16); f0[3] += __uint_as_float(ww.y & 0xffff0000u);
                    f1[0] += __uint_as_float(ww.z << 16); f1[1] += __uint_as_float(ww.z & 0xffff0000u); f1[2] += __uint_as_float(ww.w << 16); f1[3] += __uint_as_float(ww.w & 0xffff0000u); }
                const LAS f32x4* gp = P_g2 + mi * 512 + 2 * (lane + 64 * jj);
                const f32x4 x0 = {__uint_as_float(xw[g].x << 16), __uint_as_float(xw[g].x & 0xffff0000u), __uint_as_float(xw[g].y << 16), __uint_as_float(xw[g].y & 0xffff0000u)};
                const f32x4 x1 = {__uint_as_float(xw[g].z << 16), __uint_as_float(xw[g].z & 0xffff0000u), __uint_as_float(xw[g].w << 16), __uint_as_float(xw[g].w & 0xffff0000u)};
                v[2 * jj] = x0 * ALPHA + gp[0] * (f0 * (YG_F8 ? 1.0f / YG8_SCALE : 1.0f)); v[2 * jj + 1] = x1 * ALPHA + gp[1] * (f1 * (YG_F8 ? 1.0f / YG8_SCALE : 1.0f));
                s += ((v[2 * jj][0] + v[2 * jj][1]) + (v[2 * jj][2] + v[2 * jj][3])) + ((v[2 * jj + 1][0] + v[2 * jj + 1][1]) + (v[2 * jj + 1][2] + v[2 * jj + 1][3])); }
            asm volatile("" ::: "memory"); }
        const float mean = wave_sum(s) * (1.f / DM); float s2 = 0.f;
#pragma unroll
        for (int j = 0; j < 8; ++j) { v[j] = v[j] - mean; s2 += (v[j][0] * v[j][0] + v[j][1] * v[j][1]) + (v[j][2] * v[j][2] + v[j][3] * v[j][3]); }
        const float rstd = 1.f / sqrtf(wave_sum(s2) * (1.f / DM) + LN_EPS); s = 0.f;
#pragma unroll
        for (int j = 0; j < 8; ++j) { const int ci = 2 * (lane + 64 * (j >> 1)) + (j & 1);
            v[j] = v[j] * rstd * P_lg[ci] + P_lb[ci]; s += (v[j][0] + v[j][1]) + (v[j][2] + v[j][3]); }
        if (l == NLAYER - 1) {
#pragma unroll
            for (int j = 0; j < 8; ++j) ((f32x4*)dst)[2 * (lane + 64 * (j >> 1)) + (j & 1)] = v[j];
        } else {
#pragma unroll
            for (int jj = 0; jj < 4; ++jj) ((u32x4*)dstb)[lane + 64 * jj] = (u32x4){pk_bf16(v[2 * jj][0], v[2 * jj][1]), pk_bf16(v[2 * jj][2], v[2 * jj][3]), pk_bf16(v[2 * jj + 1][0], v[2 * jj + 1][1]), pk_bf16(v[2 * jj + 1][2], v[2 * jj + 1][3])}; }
        if (l + 1 < NLAYER) {
            bf16* A1 = (bf16*)(wsb() + WS_A1);
            const float mean1 = wave_sum(s) * (1.f / DM); float q2 = 0.f;
#pragma unroll
            for (int j = 0; j < 8; ++j) { v[j] = v[j] - mean1; q2 += (v[j][0] * v[j][0] + v[j][1] * v[j][1]) + (v[j][2] * v[j][2] + v[j][3] * v[j][3]); }
            const float rstd1 = 1.f / sqrtf(wave_sum(q2) * (1.f / DM) + LN_EPS);
#pragma unroll
            for (int jj = 0; jj < 4; ++jj) { const int ci = 2 * (lane + 64 * jj);
                const f32x4 o0 = v[2 * jj] * rstd1 * (P_sc[mi * 512 + ci] + 1.f) + P_sh[mi * 512 + ci], o1 = v[2 * jj + 1] * rstd1 * (P_sc[mi * 512 + ci + 1] + 1.f) + P_sh[mi * 512 + ci + 1];
#if NEED_A1F
                {   int wa = 0, wb = 0; wa = cvt2_fp8(o0[0], o0[1], wa, false); wa = cvt2_fp8(o0[2], o0[3], wa, true);
                    wb = cvt2_fp8(o1[0], o1[1], wb, false); wb = cvt2_fp8(o1[2], o1[3], wb, true);
                    ((u32x2*)(wsb() + WS_A1F + (size_t)r * DM))[lane + 64 * jj] = (u32x2){(unsigned)wa, (unsigned)wb}; }
#endif
#if NEED_A1B
                {   u32x4 w; w.x = pk_bf16(o0[0], o0[1]); w.y = pk_bf16(o0[2], o0[3]); w.z = pk_bf16(o1[0], o1[1]); w.w = pk_bf16(o1[2], o1[3]);
                    ((u32x4*)(A1 + (size_t)r * DM))[lane + 64 * jj] = w; }
#endif
            } }
    }
}

#ifndef PROBE_SUB
#define PROBE_SUB 7
#endif
#define CONV_GRP(b) (((b) >> 3) & 3)
#ifndef PROBE_NOSTORE
#define PROBE_NOSTORE 0
#endif
constexpr int PH_PER_LAYER = 10, N_PHASES = 1 + NLAYER * PH_PER_LAYER;
__global__ void __launch_bounds__(NTHR, 2) mk_fwd(Args a) {
    extern __shared__ __attribute__((aligned(16))) unsigned char lds_raw[];
    LAS unsigned char* lds = (LAS unsigned char*)lds_raw;
    const int wave = __builtin_amdgcn_readfirstlane((int)threadIdx.x >> 6);
#define tid (wave * 64 + lane_now())
#define lane lane_now()
    const int G0 = gridDim.x, bid0 = blockIdx.x;
    volatile LAS unsigned* LW = (volatile LAS unsigned*)(lds + LDSCTL_OFF);
    for (int u = tid; u < LDSCTL_BYTES / 4; u += NTHR) LW[u] = 0u;
    __syncthreads();
    unsigned* ctl = (unsigned*)(wsb() + WS_CTL);
    XcdBarrier bar; bar.bar = ctl + CW_BAR + a.li * XCD_BAR_WORDS; bar.x = 0; bar.st = nullptr;
    const bool multi = (a.ph_hi - a.ph_lo) > 1;
    if (multi) bar = xcd_barrier_post(ctl + CW_BAR + a.li * XCD_BAR_WORDS, LW + LW_BAR, wave == 0 && lane_now() == 0);
    const int lo = a.ph_lo, hi = a.ph_hi;
#ifndef PHMASK
#define PHMASK 0x7ff
#endif
#define PHC(j) ((PHMASK >> (j)) & 1)
#define IN(k) (lo <= (k) && (k) < hi)
#define SEAM(k) do { if (IN(k) && IN((k) + 1)) xcd_barrier(bar, wave == 0 && lane_now() == 0); } while (0)
#define FRESH() int G = G0, bid = bid0; asm volatile("" : "+s"(G), "+s"(bid))

    if (PHC(0) && IN(0)) { FRESH(); p0_prologue(a, lds, G, bid, tid, wave, lane); }
    SEAM(0);

    for (int l = 0; l < NLAYER; ++l) {
        const int pb = 1 + l * PH_PER_LAYER;
        if (l == 0) {
        if (PHC(1) && IN(pb + 0)) { FRESH(); p_ln1(a, l, G, bid, wave, lane); for (int fl = 0; fl < NLAYER; ++fl) p_filt(fl, G, bid, wave, lane); }
        SEAM(pb + 0);
        }
        if (PHC(2) && IN(pb + 1)) { FRESH();
            constexpr int RSH = F8_HY ? DM : 2 * DM; constexpr bool F8H = F8_HY; const float invH = F8_HY ? 1.0f / W8_SCALE : 1.0f;
            constexpr int T0 = F8_C0 / 256, T1 = F8_C1 / 256, NT8 = T1 - T0, NT16 = 16 - NT8;
            const unsigned char* wbase = wsb() + WS_WINT + (size_t)l * DIN * DM * 2;
            const unsigned char* rb = wbase + (size_t)NHY * DM * 2;
            const bf16* WinT = (const bf16*)wbase; const bf16* A1H = (const bf16*)(wsb() + (F8_HY ? WS_A1F : WS_A1));
            int cstart = bid;
            if constexpr (NT16 > 0) {
                pg8::PlainSched<2 * DM> S; S.T.init(M / 256, NT16, G, cstart); S.A = (const bf16*)(wsb() + WS_A1); S.Bt = (const bf16*)rb; S.skipctx = 0; S.lw = (const volatile LAS int*)(LW + LW_MISC + 100);
                S.pn_from = T0; S.pn_len = NT8;
                constexpr bool QKB = ATT_QK8 && !(T0 <= 4 && T1 >= 12);
                pg8::EpiU<QKB> E{(bf16*)(wsb() + WS_U), (const float*)(wsb() + WS_ROPE), 1.0f};
                pg8::gemm_phase<2 * DM, false, pg8::EpiU<QKB>, pg8::PlainSched<2 * DM>, true>(lds, S, E, wave);
                cstart = (cstart + G - ((M / 256 * NT16) % G)) % G; }
            if constexpr (NT8 > 0) {
                pg8::PlainSched<DM> S; S.T.init(M / 256, NT8, G, cstart); S.A = (const bf16*)(wsb() + WS_A1F); S.Bt = (const bf16*)(rb + (size_t)F8_C0 * DM); S.skipctx = 0; S.lw = (const volatile LAS int*)(LW + LW_MISC + 100);
                S.pn_from = 0; S.pn_len = T0;
                constexpr bool QKA = ATT_QK8 && (T0 < 12 && T1 > 4);
                pg8::EpiU<QKA> E{(bf16*)(wsb() + WS_U), (const float*)(wsb() + WS_ROPE), 1.0f / W8_SCALE};
                pg8::gemm_phase<DM, true, pg8::EpiU<QKA>, pg8::PlainSched<DM>, true>(lds, S, E, wave);
                cstart = (cstart + G - ((M / 256 * NT8) % G)) % G; }
            {   pg8::PlainSched<RSH> S; S.T.init(NHY / 256, M / 256, G, cstart); S.A = WinT; S.Bt = A1H; S.skipctx = 0; S.lw = (const volatile LAS int*)(LW + LW_MISC + 100);
                pg8::EpiBf16 E{(bf16*)(wsb() + WS_HYT), M, invH};
                pg8::gemm_phase<RSH, F8H, pg8::EpiBf16, pg8::PlainSched<RSH>, true>(lds, S, E, wave); }
        }
        SEAM(pb + 1);
        if (PHC(3) && IN(pb + 2)) { FRESH();
#ifndef MIX1SEL
#define MIX1SEL 7
#endif
#ifndef PROBE_SUB
#define PROBE_SUB 7
#endif
            const bool rep = (a.li > 0) && (lo == pb + 2);
            if (CONV_GRP(bid) == 0) moe_conv(l, lds, G, bid, wave, lane);
            if ((MIX1SEL & 1) && (!rep || (PROBE_SUB & 1))) for (int c = bid; c < HYW; c += G) hyena_lat_unit(a, l, c, lds, tid, wave, lane);
#if ATT_NV == 2
            if (CONV_GRP(bid) == 2) moe_conv(l, lds, G, bid, wave, lane);
#endif
            if ((MIX1SEL & 2) && (!rep || (PROBE_SUB & 2))) for (int c = bid; c < (l == NLAYER - 1 ? 0 : HYW); c += G) hyena_ctx_unit(a, l, c, lds, tid, wave, lane);
            if ((MIX1SEL & 4) && (!rep || (PROBE_SUB & 4))) for (int u = bid; u < NB * 8 * LRU_NCH; u += G) lru_unit<1>(a, l, u, lds, tid, wave, lane);
            if (CONV_GRP(bid) == 1) moe_conv(l, lds, G, bid, wave, lane);
        }
        if (PHC(4) && IN(pb + 3)) { FRESH();
            const bf16* U = (const bf16*)(wsb() + WS_U); float* OATT = (float*)(wsb() + WS_OATT);
#ifndef MIX2SEL
#define MIX2SEL 3
#endif
#if ATT_NV == 2
            if (MIX2SEL & 1) for (int u = bid; u < 256 + (l == NLAYER - 1 ? 0 : 16); u += G) {
                int b, h, mp, qrow, seq;
                if (u < 256) { const int qb = (u >> 3) & 15; mp = u & 1; h = (u >> 1) & 3; b = u >> 7; qrow = b * RB + CTXL + qb * 256; seq = RB; }
                else { const int v = u - 256; mp = v & 1; h = (v >> 1) & 3; b = v >> 3; qrow = b * RB; seq = CTXL; }
                float* Ob = OATT + ((size_t)mp * M + qrow) * 1024 + h * 256;
                const unsigned char* Q8 = wsb() + WS_QK8 + (size_t)qrow * DM + (h * 2 + mp) * 128;
                const unsigned char* K8 = wsb() + WS_QK8 + (size_t)(b * RB) * DM + 1024 + (h * 2 + mp) * 128;
                const unsigned char* V8 = wsb() + WS_VT8 + ((size_t)(b * 4 + h) * 256) * RB;
                att::attn_dense_body_f8x2<DM, DM, RB, 1024>(Q8, K8, V8, Ob, seq, (char*)lds_raw, lds, wave, (PROBE_DEG && hi == pb + 4) ? PROBE_DEG : 0);
            }
#else
            if (MIX2SEL & 1) for (int u = bid; u < 512 + (l == NLAYER - 1 ? 0 : 32); u += G) {
                if (u >= G && u < 2 * G && CONV_GRP(bid) == 2) moe_conv(l, lds, G, bid, wave, lane);
                int b, h, mp, vh, qrow, seq;
                if (u < 512) { const int qb = (u >> 3) & 15; vh = (u >> 7) & 1; mp = u & 1; h = (u >> 1) & 3; b = u >> 8; qrow = b * RB + CTXL + qb * 256; seq = RB; }
                else { const int v = u - 512; vh = v & 1; mp = (v >> 1) & 1; h = (v >> 2) & 3; b = v >> 4; qrow = b * RB; seq = CTXL; }
                const bf16* Vh = U + (size_t)(b * RB) * NREST + UC_V + h * 256 + vh * 128;
                float* Ob = OATT + ((size_t)mp * M + qrow) * 1024 + h * 256 + vh * 128;
#if ATT_QK8
                const unsigned char* Q8 = wsb() + WS_QK8 + (size_t)qrow * DM + (h * 2 + mp) * 128;
                const unsigned char* K8 = wsb() + WS_QK8 + (size_t)(b * RB) * DM + 1024 + (h * 2 + mp) * 128;
#if ATT_PV8
                const unsigned char* V8 = wsb() + WS_VT8 + ((size_t)(b * 4 + h) * 256 + vh * 128) * RB;
                att::attn_dense_body_f8<1, DM, DM, RB, 1024>(Q8, K8, V8, Ob, seq, (char*)lds_raw, wave);
#else
                att::attn_dense_body_qk8<DM, DM, NREST, 1024>(Q8, K8, Vh, Ob, seq, (char*)lds_raw, wave);
#endif
#else
                const bf16* Qb = U + (size_t)qrow * NREST + UC_Q + (h * 2 + mp) * 128;
                const bf16* Kh = U + (size_t)(b * RB) * NREST + UC_K + (h * 2 + mp) * 128;
                att::attn_dense_body<NREST, NREST, 1024>(Qb, Kh, Vh, Ob, seq, (char*)lds_raw, wave);
#endif
            }
#endif
            if (CONV_GRP(bid) == 3 && !((a.li > 0) && (lo == pb + 3))) moe_conv(l, lds, G, bid, wave, lane);
        }
        SEAM(pb + 3);
        if (PHC(5) && IN(pb + 4)) { FRESH(); const bool rep5 = (a.li > 0) && (lo == pb + 4); const int sub5 = rep5 ? PROBE_SUB : 7; p_mix3(a, l, lds, G, bid, tid, wave, lane, sub5);
            if (sub5 & 4) {
                if (l == NLAYER - 1) { for (int v = bid; v < NB * 8 * (LRU_NCH - 2); v += G) lru_unit<2>(a, l, (v / (LRU_NCH - 2)) * LRU_NCH + 2 + v % (LRU_NCH - 2), lds, tid, wave, lane); }
                else for (int u = bid; u < NB * 8 * LRU_NCH; u += G) lru_unit<2>(a, l, u, lds, tid, wave, lane); } }
        SEAM(pb + 4);
        if (PHC(6) && IN(pb + 5)) { FRESH();
            const int last = (l == NLAYER - 1);
            if (bid == 0 && tid < 64 && !((a.li > 0) && (lo == pb + 5) && !(PROBE_SUB & 4))) ((unsigned*)(wsb() + WS_CTL))[CW_CNT + (64 * l + tid) * CNT_ST] = 0u;
#if FP8_OUT
            constexpr int RSO = DM; constexpr bool F8O = true; const float invO = 1.0f / (W8_SCALE * MIX8_SCALE); const bf16* WoT = (const bf16*)(wsb() + WS_WOUTT + (size_t)l * DM * DM);
#else
            constexpr int RSO = 2 * DM; constexpr bool F8O = false; const float invO = 1.0f; const bf16* WoT = (const bf16*)(wsb() + WS_WOUTT) + (size_t)l * DM * DM;
#endif
            pg8::PlainSched<RSO> S; S.T.init(last ? 32 : M / 256, DM / 256, G, bid); S.skipctx = last; S.lw = (const volatile LAS int*)(LW + LW_MISC + 100); S.A = (const bf16*)(wsb() + WS_MIX); S.Bt = WoT;
            pg8::EpiOut E{l, invO};
            pg8::gemm_phase<RSO, F8O, pg8::EpiOut, pg8::PlainSched<RSO>, true>(lds, S, E, wave);
        }
        SEAM(pb + 5);
        if (PHC(7) && IN(pb + 6)) { FRESH(); const bool rep2 = (a.li > 0) && (lo == pb + 5); p_ln2(a, l, lds, G, bid, tid, wave, lane, rep2 ? PROBE_SUB : 7); }
        SEAM(pb + 6);
        if (IN(pb + 7) || IN(pb + 8)) {
            const unsigned* cnt = (const unsigned*)(wsb() + WS_CTL) + CW_CNT + 64 * l * CNT_ST;
            if (tid < NEXP) LW[LW_MISC + tid] = __hip_atomic_load(cnt + tid * CNT_ST, RLX_AGENT);
            __syncthreads();
            if (tid == 0) { int acc = 0, nf = 0, nt = 0;
                for (int e = 0; e < NEX1; ++e) { LW[LW_TPRE + e] = (unsigned)acc; LW[LW_FPRE + e] = (unsigned)nf; const int c = (e < NEXP) ? (int)LW[LW_MISC + e] : (l == NLAYER - 1 ? NB * SEQ : M); const int t = (c + 255) / 256;
                    acc += t; if (t > 0) { nf += t - 1; LW[LW_FPRE + NEX1 + 2 + nt] = (unsigned)e; ++nt; } }
                LW[LW_TPRE + NEX1] = (unsigned)acc; LW[LW_FPRE + NEX1] = (unsigned)nf; LW[LW_FPRE + NEX1 + 1] = (unsigned)nt; }
            __syncthreads();
            if (tid < 48) { volatile LAS int* UL = (volatile LAS int*)(lds + ULIST_OFF); const int ph2 = tid >= 16 ? 1 : 0, i = ph2 ? tid - 16 : tid, NTN = ph2 ? 8 : 4;
                const int nfull = (int)LW[LW_FPRE + NEX1], ntail = (int)LW[LW_FPRE + NEX1 + 1]; const int cx = (G0 & 7) ? bid0 : (bid0 & 7) * (G0 >> 3) + (bid0 >> 3);
                const int L = i * G0 + cx; int e = -1, rt = 0, pn = 0, pm = 0;
                if (L < (nfull + ntail) * NTN) { const int ti = L / NTN; pn = L % NTN;
                    if (ti < nfull) { int lo_ = 0, hi_ = NEX1; while (hi_ - lo_ > 1) { const int mid = (lo_ + hi_) >> 1; if ((int)LW[LW_FPRE + mid] <= ti) lo_ = mid; else hi_ = mid; } e = lo_; rt = ti - (int)LW[LW_FPRE + e]; }
                    else { e = (int)LW[LW_FPRE + NEX1 + 2 + (ti - nfull)]; rt = (int)LW[LW_TPRE + e + 1] - (int)LW[LW_TPRE + e] - 1; }
                    pm = (int)LW[LW_TPRE + e] + rt; }
                UL[4 * tid] = e; UL[4 * tid + 1] = rt; UL[4 * tid + 2] = pn; UL[4 * tid + 3] = pm; }
            __syncthreads();
        }
        if (PHC(8) && IN(pb + 7)) { FRESH();
            pg8::MoeSched<DM, 4, true> S; S.tpre = (const volatile LAS int*)(LW + LW_TPRE); S.fpre = (const volatile LAS int*)(LW + LW_FPRE); S.G = G; S.c = (G & 7) ? bid : (bid & 7) * (G >> 3) + (bid >> 3); S.A = wsb() + WS_H2; S.Bt = wsb() + WS_W1T + (size_t)l * NEX1 * 1024 * DM;
            S.ltok = (const int*)(wsb() + WS_LIST); S.cnt = (const volatile LAS int*)(LW + LW_MISC); S.latent_only = (l == NLAYER - 1);
            S.ulist = (const volatile LAS int*)(lds + ULIST_OFF); S.ucap = 16;
            pg8::EpiMoe1 E{wsb() + WS_ACT, 1.0f / W8_SCALE};
            pg8::gemm_phase<DM, true, pg8::EpiMoe1, pg8::MoeSched<DM, 4, true>, true>(lds, S, E, wave);
        }
        SEAM(pb + 7);
        if (PHC(9) && IN(pb + 8)) { FRESH();
#ifndef MOE2_STAGGER
#define MOE2_STAGGER 0
#endif
            if (MOE2_STAGGER > 0 && ((bid >> 3) & 1)) { for (int i = 0; i < MOE2_STAGGER; ++i) __builtin_amdgcn_s_sleep(127); }
            pg8::MoeSched<DEXP, 8, false> S; S.tpre = (const volatile LAS int*)(LW + LW_TPRE); S.fpre = (const volatile LAS int*)(LW + LW_FPRE); S.G = G; S.c = (G & 7) ? bid : (bid & 7) * (G >> 3) + (bid >> 3); S.A = wsb() + WS_ACT; S.Bt = wsb() + WS_W2T + (size_t)l * NEX1 * DM * DEXP;
            S.ltok = nullptr; S.cnt = (const volatile LAS int*)(LW + LW_MISC); S.latent_only = (l == NLAYER - 1);
            S.ulist = (const volatile LAS int*)(lds + ULIST_OFF + 16 * 16); S.ucap = 32;
            const int* ltok = (const int*)(wsb() + WS_LIST);
            pg8::EpiMoe2 E{(bf16*)(wsb() + WS_YG), ltok + (size_t)NEXP * LCAP, ltok + (size_t)2 * NEXP * LCAP, (const volatile LAS int*)(LW + LW_MISC), (l == NLAYER - 1), 1.0f / W8_SCALE, (PROBE_NOSTORE == 2) ? ((hi == pb + 9) ? 2 : 0) : (PROBE_NOSTORE == 3) ? (((a.li > 0) && (lo == pb + 8)) ? 3 : 0) : (PROBE_NOSTORE && (a.li > 0) && (lo == pb + 8))};
            pg8::gemm_phase<DEXP, true, pg8::EpiMoe2, pg8::MoeSched<DEXP, 8, false>, true>(lds, S, E, wave);
        }
        SEAM(pb + 8);
        if (PHC(10) && IN(pb + 9)) { FRESH(); p_ffnln(a, l, lds, G, bid, wave, lane); }
        SEAM(pb + 9);
    }
#undef IN
#undef SEAM
#undef tid
#undef lane
}

extern "C" void kernel_launch(void* const* d_in, const int* in_sizes, int n_in, void* d_out, int out_size, void* d_ws, size_t ws_size, hipStream_t stream) {
    static int grid = 0;
    if (grid == 0) {
        if (n_in != 36 || out_size != NB * SEQ * DM || ws_size < WS_END) { fprintf(stderr, "kernel_launch: built for 36 inputs, %d outputs, >= %zu bytes of workspace; got n_in %d, out %d, ws %zu; nothing launched\n", NB * SEQ * DM, (size_t)WS_END, n_in, out_size, ws_size); grid = -1; return; }
        int dev = 0, cus = 0, per_cu = 0;
        if (hipGetDevice(&dev) != hipSuccess || hipDeviceGetAttribute(&cus, hipDeviceAttributeMultiprocessorCount, dev) != hipSuccess) { fprintf(stderr, "kernel_launch: device query failed\n"); grid = -1; return; }
        if (hipFuncSetAttribute((const void*)mk_fwd, hipFuncAttributeMaxDynamicSharedMemorySize, LDS_BYTES) != hipSuccess) { fprintf(stderr, "kernel_launch: hipFuncSetAttribute(%d B LDS) failed\n", LDS_BYTES); grid = -1; return; }
        if (hipOccupancyMaxActiveBlocksPerMultiprocessor(&per_cu, (const void*)mk_fwd, NTHR, LDS_BYTES) != hipSuccess || per_cu < 1) { fprintf(stderr, "kernel_launch: occupancy query says %d blocks per CU\n", per_cu); (void)hipGetLastError(); grid = -1; return; }
        grid = cus;
    }
    if (grid < 0) return;
    if (hipMemsetAsync((char*)d_ws + WS_CTL, 0, CTL_ZERO_BYTES, stream) != hipSuccess) { fprintf(stderr, "kernel_launch: memset failed\n"); return; }
    Args a{};
    for (int i = 0; i < 36; ++i) a.in[i] = (const float*)d_in[i];
    a.out = (float*)d_out; a.ws = (unsigned char*)d_ws;
#if defined(PROBE_REP)
    {   const int j = PROBE_REP; int lo[3], hi[3], n;
        if (j == 0) { lo[0] = 0; hi[0] = 1; lo[1] = 0; hi[1] = N_PHASES; n = 2; }
        else {
#ifdef PROBE_REP_HI
            const int j1 = PROBE_REP_HI;
#else
            const int j1 = j;
#endif
            lo[0] = 0; hi[0] = j1 + 1; lo[1] = j; hi[1] = PH_PER_LAYER + j1 + 1; lo[2] = PH_PER_LAYER + j; hi[2] = N_PHASES; n = 3; }
        for (int i = 0; i < n; ++i) { a.ph_lo = lo[i]; a.ph_hi = hi[i]; a.li = i; hipLaunchKernelGGL(mk_fwd, dim3(grid), dim3(NTHR), LDS_BYTES, stream, a); } }
#elif MK_N_LAUNCHES == 1
    a.ph_lo = 0; a.ph_hi = N_PHASES;
    hipLaunchKernelGGL(mk_fwd, dim3(grid), dim3(NTHR), LDS_BYTES, stream, a);
#else
    for (int p = 0; p < N_PHASES; ++p) { a.ph_lo = p; a.ph_hi = p + 1; hipLaunchKernelGGL(mk_fwd, dim3(grid), dim3(NTHR), LDS_BYTES, stream, a); }
#endif
    const hipError_t le = hipPeekAtLastError();
    if (le != hipSuccess) fprintf(stderr, "kernel_launch: launch failed: %s\n", hipGetErrorName(le));
}
```
